# Optimizing an MI355X kernel written in HIP

```python
import math
import jax
import jax.numpy as jnp
from jax import lax
import numpy as np

D_MODEL = 1024
BATCH = 8
SEQ = 4096
DEPTH = 1

D_MIX = D_MODEL
D_MLSTM = D_MIX // 2
N_MLSTM_HEADS = 4
MLSTM_HEAD_DIM = D_MLSTM // N_MLSTM_HEADS
D_CONV = D_MIX - D_MLSTM
CONV_WIDTH = 3
CHUNK = 64
FORGET_BIAS_LO = 3.0
FORGET_BIAS_HI = 6.0
N_GROUPS = 4
EXPERTS_PER_GROUP = 8
N_EXPERTS = N_GROUPS * EXPERTS_PER_GROUP
TOP_K = 2
D_FF_EXPERT = D_MODEL // 2
MOE_BLOCK = 128
RMS_EPS = 1e-6

F_OFF = 4 * D_MLSTM + N_MLSTM_HEADS
D_PROJ = 4 * D_MLSTM + 2 * N_MLSTM_HEADS + 3 * D_CONV
SPLIT_POINTS = (
    D_MLSTM,
    2 * D_MLSTM,
    3 * D_MLSTM,
    4 * D_MLSTM,
    4 * D_MLSTM + N_MLSTM_HEADS,
    4 * D_MLSTM + 2 * N_MLSTM_HEADS,
    4 * D_MLSTM + 2 * N_MLSTM_HEADS + D_CONV,
    4 * D_MLSTM + 2 * N_MLSTM_HEADS + 2 * D_CONV,
)

kernel_name = "hymba_mlstm_shortconv_hmoe_block"


def rms_norm(x, g):
    xf = x.astype(jnp.float32)
    y = xf * lax.rsqrt(jnp.mean(xf * xf, axis=-1, keepdims=True) + RMS_EPS)
    return (y * g.astype(jnp.float32)).astype(x.dtype)


def mlstm_chunkwise(q, k, v, log_i, log_f):
    b_sz, s_len, n_h, d_h = q.shape
    n_c = s_len // CHUNK

    def to_chunks(t):
        return t.reshape(b_sz, n_c, CHUNK, n_h, d_h).transpose(0, 3, 1, 2, 4)

    def gate_chunks(t):
        return t.reshape(b_sz, n_c, CHUNK, n_h).transpose(0, 3, 1, 2)

    qc, kc, vc = to_chunks(q), to_chunks(k), to_chunks(v)
    li, lf = gate_chunks(log_i), gate_chunks(log_f)

    b_cum = jnp.cumsum(lf, axis=-1)
    g_tot = b_cum[..., -1]
    a_end = g_tot[..., None] - b_cum + li
    m_loc = jnp.max(a_end, axis=-1)

    def step(carry, xs):
        c_st, n_st, m_st = carry
        k_c, v_c, a_c, g_c, ml_c = xs
        m_new = jnp.maximum(g_c + m_st, ml_c)
        decay = jnp.exp(g_c + m_st - m_new)
        w = jnp.exp(a_c - m_new[..., None])
        c_new = decay[..., None, None] * c_st + jnp.einsum('bhl,bhle,bhld->bhed', w, v_c, k_c)
        n_new = decay[..., None] * n_st + jnp.einsum('bhl,bhld->bhd', w, k_c)
        return (c_new, n_new, m_new), (c_st, n_st, m_st)

    init = (
        jnp.zeros((b_sz, n_h, d_h, d_h), jnp.float32),
        jnp.zeros((b_sz, n_h, d_h), jnp.float32),
        jnp.zeros((b_sz, n_h), jnp.float32),
    )
    xs = (
        jnp.moveaxis(kc, 2, 0),
        jnp.moveaxis(vc, 2, 0),
        jnp.moveaxis(a_end, 2, 0),
        jnp.moveaxis(g_tot, 2, 0),
        jnp.moveaxis(m_loc, 2, 0),
    )
    _, (c_prev, n_prev, m_prev) = lax.scan(step, init, xs)
    c_prev = jnp.moveaxis(c_prev, 0, 2)
    n_prev = jnp.moveaxis(n_prev, 0, 2)
    m_prev = jnp.moveaxis(m_prev, 0, -1)

    causal = jnp.tril(jnp.ones((CHUNK, CHUNK), dtype=bool))
    d_log = b_cum[..., :, None] - b_cum[..., None, :] + li[..., None, :]
    d_log = jnp.where(causal, d_log, -jnp.inf)
    inter_log = b_cum + m_prev[..., None]
    m_t = jnp.maximum(inter_log, jnp.max(d_log, axis=-1))
    scores = jnp.einsum('bhcld,bhcjd->bhclj', qc, kc) * jnp.exp(d_log - m_t[..., None])
    w_inter = jnp.exp(inter_log - m_t)
    num = jnp.einsum('bhclj,bhcje->bhcle', scores, vc) + w_inter[..., None] * jnp.einsum(
        'bhced,bhcld->bhcle', c_prev, qc)
    den = jnp.sum(scores, axis=-1) + w_inter * jnp.einsum('bhcd,bhcld->bhcl', n_prev, qc)
    h = num / jnp.maximum(jnp.abs(den), jnp.exp(-m_t))[..., None]
    return h.transpose(0, 2, 3, 1, 4).reshape(b_sz, s_len, n_h, d_h)


def short_gated_conv(gate_b, gate_c, xin, conv_w):
    u = gate_c * xin
    up = jnp.pad(u, ((0, 0), (CONV_WIDTH - 1, 0), (0, 0)))
    s_len = u.shape[1]
    z = conv_w[0] * up[:, 0:s_len] + conv_w[1] * up[:, 1:s_len + 1] + conv_w[2] * up[:, 2:s_len + 2]
    return gate_b * z


def hier_moe(h, w_group, b_group, w_expert, b_expert, w_gate, w_up, w_down):
    n_tok, d = h.shape
    hf = h.astype(jnp.float32)
    group_logits = hf @ w_group.astype(jnp.float32) + b_group.astype(jnp.float32)
    group_prob = jax.nn.softmax(group_logits, axis=-1)
    g_sel = jnp.argmax(group_logits, axis=-1)
    p_g = jnp.take_along_axis(group_prob, g_sel[:, None], axis=1)[:, 0]
    exp_logits = (hf @ w_expert.astype(jnp.float32) + b_expert.astype(jnp.float32)).reshape(
        n_tok, N_GROUPS, EXPERTS_PER_GROUP)
    in_group = jnp.take_along_axis(exp_logits, g_sel[:, None, None], axis=1)[:, 0]
    top_val, top_idx = lax.top_k(in_group, TOP_K)
    top_w = jax.nn.softmax(top_val, axis=-1) * p_g[:, None]
    expert_id = g_sel[:, None] * EXPERTS_PER_GROUP + top_idx

    nk = n_tok * TOP_K
    flat_e = expert_id.reshape(nk).astype(jnp.int32)
    flat_tok = jnp.repeat(jnp.arange(n_tok, dtype=jnp.int32), TOP_K)
    flat_w = top_w.reshape(nk).astype(h.dtype)

    counts = jnp.bincount(flat_e, length=N_EXPERTS)
    starts = jnp.cumsum(counts) - counts
    padded = ((counts + MOE_BLOCK - 1) // MOE_BLOCK) * MOE_BLOCK
    pends = jnp.cumsum(padded)
    pstarts = pends - padded
    order = jnp.argsort(flat_e)
    sorted_e = flat_e[order]
    rank = jnp.arange(nk, dtype=jnp.int32) - starts[sorted_e]
    dest = pstarts[sorted_e] + rank

    n_blocks = -(-nk // MOE_BLOCK) + N_EXPERTS
    cap = n_blocks * MOE_BLOCK
    buf_tok = jnp.zeros((cap,), jnp.int32).at[dest].set(flat_tok[order])
    buf_w = jnp.zeros((cap,), h.dtype).at[dest].set(flat_w[order])
    block_start = jnp.arange(n_blocks, dtype=jnp.int32) * MOE_BLOCK
    block_e = jnp.clip(jnp.searchsorted(pends, block_start, side='right'), 0, N_EXPERTS - 1)

    xb = h[buf_tok].reshape(n_blocks, MOE_BLOCK, d)

    def expert_block(args):
        x_blk, e = args
        a = x_blk @ w_gate[e]
        u = x_blk @ w_up[e]
        return (jax.nn.silu(a) * u) @ w_down[e]

    yb = lax.map(expert_block, (xb, block_e)).reshape(cap, d)
    return jnp.zeros((n_tok, d), h.dtype).at[buf_tok].add(buf_w[:, None] * yb)


def hybrid_layer(x, norm_mix, w_in, b_in, conv_w, w_out, norm_ffn,
                 w_group, b_group, w_expert, b_expert, w_gate, w_up, w_down):
    b_sz, s_len, d = x.shape
    hn = rms_norm(x, norm_mix)
    proj = hn @ w_in + b_in
    q, k, v, o, ig, fg, cb, cc, cx = jnp.split(proj, SPLIT_POINTS, axis=-1)
    heads = (b_sz, s_len, N_MLSTM_HEADS, MLSTM_HEAD_DIM)
    qf = q.astype(jnp.float32).reshape(heads) * (MLSTM_HEAD_DIM ** -0.5)
    kf = k.astype(jnp.float32).reshape(heads)
    vf = v.astype(jnp.float32).reshape(heads)
    log_i = ig.astype(jnp.float32)
    log_f = jax.nn.log_sigmoid(fg.astype(jnp.float32))
    h_m = mlstm_chunkwise(qf, kf, vf, log_i, log_f).reshape(b_sz, s_len, D_MLSTM)
    y_m = (jax.nn.sigmoid(o.astype(jnp.float32)) * h_m).astype(x.dtype)
    y_c = short_gated_conv(cb, cc, cx, conv_w)
    x = x + jnp.concatenate([y_m, y_c], axis=-1) @ w_out
    hn2 = rms_norm(x, norm_ffn)
    moe = hier_moe(hn2.reshape(b_sz * s_len, d), w_group, b_group, w_expert, b_expert,
                   w_gate, w_up, w_down)
    return x + moe.reshape(b_sz, s_len, d)


def setup_inputs(seed: int = 0) -> dict:
    key = jax.random.key(seed)
    ks = jax.random.split(key, 16)
    nrm = jax.random.normal
    x = nrm(ks[0], (BATCH, SEQ, D_MODEL), jnp.float32)
    norm_mix = 1.0 + 0.02 * nrm(ks[1], (DEPTH, D_MODEL), jnp.float32)
    w_in = nrm(ks[2], (DEPTH, D_MODEL, D_PROJ), jnp.float32) * (D_MODEL ** -0.5)
    b_in = 0.01 * nrm(ks[3], (DEPTH, D_PROJ), jnp.float32)
    b_in = b_in.at[:, F_OFF:F_OFF + N_MLSTM_HEADS].add(
        jnp.linspace(FORGET_BIAS_LO, FORGET_BIAS_HI, N_MLSTM_HEADS, dtype=jnp.float32))
    conv_w = nrm(ks[4], (DEPTH, CONV_WIDTH, D_CONV), jnp.float32) * (CONV_WIDTH ** -0.5)
    w_out = nrm(ks[5], (DEPTH, D_MIX, D_MODEL), jnp.float32) * (D_MIX ** -0.5)
    norm_ffn = 1.0 + 0.02 * nrm(ks[6], (DEPTH, D_MODEL), jnp.float32)
    w_group = nrm(ks[7], (DEPTH, D_MODEL, N_GROUPS), jnp.float32) * (D_MODEL ** -0.5)
    b_group = 0.01 * nrm(ks[8], (DEPTH, N_GROUPS), jnp.float32)
    w_expert = nrm(ks[9], (DEPTH, D_MODEL, N_EXPERTS), jnp.float32) * (D_MODEL ** -0.5)
    b_expert = 0.01 * nrm(ks[10], (DEPTH, N_EXPERTS), jnp.float32)
    w_gate = nrm(ks[11], (DEPTH, N_EXPERTS, D_MODEL, D_FF_EXPERT), jnp.float32) * (D_MODEL ** -0.5)
    w_up = nrm(ks[12], (DEPTH, N_EXPERTS, D_MODEL, D_FF_EXPERT), jnp.float32) * (D_MODEL ** -0.5)
    w_down = nrm(ks[13], (DEPTH, N_EXPERTS, D_FF_EXPERT, D_MODEL), jnp.float32) * (D_FF_EXPERT ** -0.5)
    norm_final = 1.0 + 0.02 * nrm(ks[14], (D_MODEL,), jnp.float32)
    return {
        'x': x, 'norm_mix': norm_mix, 'w_in': w_in, 'b_in': b_in, 'conv_w': conv_w,
        'w_out': w_out, 'norm_ffn': norm_ffn, 'w_group': w_group, 'b_group': b_group,
        'w_expert': w_expert, 'b_expert': b_expert, 'w_gate': w_gate, 'w_up': w_up,
        'w_down': w_down, 'norm_final': norm_final,
    }


def reference(x, norm_mix, w_in, b_in, conv_w, w_out, norm_ffn, w_group, b_group,
              w_expert, b_expert, w_gate, w_up, w_down, norm_final):
    for l in range(DEPTH):
        x = hybrid_layer(x, norm_mix[l], w_in[l], b_in[l], conv_w[l], w_out[l], norm_ffn[l],
                         w_group[l], b_group[l], w_expert[l], b_expert[l],
                         w_gate[l], w_up[l], w_down[l])
    return rms_norm(x, norm_final)
```

```cpp
#include <hip/hip_runtime.h>
#include <cstdio>
#include <cstdint>

#ifndef MK_N_LAUNCHES
#define MK_N_LAUNCHES 1
#endif

#define LAS __attribute__((address_space(3)))
#define GAS __attribute__((address_space(1)))
typedef unsigned short bf16_t;
typedef short bf16x8 __attribute__((ext_vector_type(8)));
typedef short s16x4 __attribute__((ext_vector_type(4)));
typedef float f32x4 __attribute__((ext_vector_type(4)));
typedef float f32x2 __attribute__((ext_vector_type(2)));
typedef unsigned u32x4 __attribute__((ext_vector_type(4)));
typedef unsigned u32x2 __attribute__((ext_vector_type(2)));

constexpr int NTOK = 32768, D = 1024, SEQ = 4096;
constexpr int NH = 4, DH = 128, CH = 64, NCH = SEQ / CH;
constexpr int NPROJ = 3584, NPROJ_IN = 3592;
constexpr int NE = 32, DFF = 512, LCAP = 32768;
constexpr int MAXTILES = 288;
constexpr float RMS_EPS = 1e-6f;

constexpr size_t MiB = 1u << 20;
constexpr size_t WS_CTL = 0, CTL_ZERO_BYTES = 64 * 1024;
constexpr size_t WS_WIN = 2 * MiB;
constexpr size_t WS_WOUT = 9 * MiB;
constexpr size_t WS_WR = 11 * MiB;
constexpr size_t WS_W1 = 12 * MiB;
constexpr size_t WS_W2 = 76 * MiB;
constexpr size_t WS_LIST = 108 * MiB;
constexpr size_t WS_LRS = 112 * MiB;
constexpr size_t WS_TOKINFO = 116 * MiB;
constexpr size_t WS_RS1 = 117 * MiB;
constexpr size_t WS_GATES = 118 * MiB;
constexpr size_t WS_R2 = 120 * MiB;
constexpr size_t WS_R1 = 184 * MiB;
constexpr size_t WS_HBUF = WS_R1, WS_Y2 = WS_R1 + 72 * MiB;
constexpr size_t WS_END = 408 * MiB;
constexpr int CW_CNT = 64;
constexpr int CW_BAR = 4096;

constexpr int RING_BYTES = 131072;
constexpr int LDSCTL_OFF = RING_BYTES, MISC_OFF = LDSCTL_OFF + 320, TB_OFF = LDSCTL_OFF + 1024, CNT_OFF = LDSCTL_OFF + 1280;
constexpr int LDS_BYTES = 147456;

typedef __bf16 bf16pair_t __attribute__((ext_vector_type(2)));
__device__ __forceinline__ unsigned cvtpk(float lo, float hi) { bf16pair_t v; v[0] = (__bf16)lo; v[1] = (__bf16)hi; return __builtin_bit_cast(unsigned, v); }
__device__ __forceinline__ float bflo(unsigned u) { return __uint_as_float(u << 16); }
__device__ __forceinline__ float bfhi(unsigned u) { return __uint_as_float(u & 0xffff0000u); }
__device__ __forceinline__ float wave_sum(float v) {
#pragma unroll
    for (int o = 1; o < 64; o <<= 1) v += __shfl_xor(v, o);
    return v;
}
#define LDS_WAIT() asm volatile("s_waitcnt lgkmcnt(0)" ::: "memory")

namespace pg8 {
constexpr int BM = 256, BK = 64, HALF = 128, HTB = HALF * BK * 2, STAGE_BYTES = 8 * HTB, NXCD = 8, WGM = 8;
__host__ __device__ __forceinline__ int lds_byte(int r, int c) { const int st = (r >> 4) * 2 + (c >> 5), rr = r & 15, cc = c & 31, ob = rr * 64 + cc * 2; return st * 1024 + (ob ^ (((ob >> 9) & 1) << 5)); }
__host__ __device__ __forceinline__ void stage_rc(int b, int& R, int& C) { const int st = b / 1024, sb = b % 1024, swz = sb ^ (((sb >> 9) & 1) << 5); R = (st >> 1) * 16 + swz / 64; C = (st & 1) * 32 + (swz % 64) / 2; }
__host__ __device__ __forceinline__ int perm32(int rho) { const int n = rho >> 4, i = rho & 15; return 8 * (i >> 2) + 4 * n + (i & 3); }

struct Unit { int pm, pn; const char* a; const char* b; int e, mt, cnt; };

__device__ __forceinline__ void tile_of(int L, int nM, int nN, int& pm, int& pn) {
    const int nwg = nM * nN; int wgid = L;
    { const int q = nwg / NXCD, r = nwg % NXCD, xcd = wgid % NXCD, off = wgid / NXCD; wgid = (xcd < r ? xcd * (q + 1) : r * (q + 1) + (xcd - r) * q) + off; }
    const int nig = WGM * nN, gid = wgid / nig, fm = gid * WGM, gsz = (nM - fm) < WGM ? (nM - fm) : WGM;
    pm = fm + ((wgid % nig) % gsz); pn = (wgid % nig) / gsz;
}
struct DenseOrder {
    static constexpr bool GATHER = false;
    int nM, nN, G, c, K; const char* A; const char* B;
    __device__ __forceinline__ bool next(int i, Unit& u) const {
        const long L = (long)i * G + c; if (L >= (long)nM * nN) return false;
        tile_of((int)L, nM, nN, u.pm, u.pn); const size_t tstep = (size_t)BM * K * 2;
        u.a = A + (size_t)u.pm * tstep; u.b = B + (size_t)u.pn * tstep; u.e = 0; u.mt = 0; u.cnt = 0; return true;
    }
    __device__ __forceinline__ void a_off(const Unit&, int, unsigned (&)[2][2]) const {}
};
template <bool GATHER_>
struct MoeOrder {
    static constexpr bool GATHER = GATHER_;
    int nM, nN, G, c, K; const char* A; const char* B; size_t b_estride; const int* list; const LAS int* tb; const LAS int* cn;
    __device__ __forceinline__ bool next(int i, Unit& u) const {
        const long L = (long)i * G + c; if (L >= (long)nM * nN) return false;
        tile_of((int)L, nM, nN, u.pm, u.pn);
        int e = 0;
#pragma unroll
        for (int j = 1; j < NE; ++j) e += (tb[j] <= u.pm) ? 1 : 0;
        u.e = e; u.mt = u.pm - tb[e]; u.cnt = cn[e];
        const size_t tstep = (size_t)BM * K * 2;
        u.b = B + (size_t)e * b_estride + (size_t)u.pn * tstep;
        u.a = GATHER ? A : A + (size_t)u.pm * tstep; return true;
    }
    __device__ __forceinline__ void a_off(const Unit& u, int tid, unsigned (&off)[2][2]) const {
        if constexpr (GATHER) {
            asm volatile("" : "+v"(tid));
#pragma unroll
            for (int i = 0; i < 2; ++i) { int R, C; stage_rc(tid * 16 + i * 8192, R, C);
#pragma unroll
                for (int h = 0; h < 2; ++h) { int idx = u.mt * BM + R + h * HALF; idx = idx < u.cnt ? idx : u.mt * BM; const int tok = list[(size_t)u.e * LCAP + idx];
                    off[h][i] = (unsigned)tok * (unsigned)(K * 2) + (unsigned)C * 2u; } }
        }
    }
};

__device__ __forceinline__ unsigned cvt_pk_bf16(float lo, float hi) { return cvtpk(lo, hi); }

struct EpiProj {
    static constexpr bool PERM = true;
    bf16_t* O; int ldc; const float* bias; const float* rowscale;
    __device__ __forceinline__ void operator()(const f32x4 (&acc)[2][2][4][2], const Unit& u, int wr, int wc, int fr, int fq) const {
        const int row0 = u.pm * BM + wr * 64 + fr, col0 = u.pn * BM + wc * 32 + 8 * fq;
        f32x4 bv[2][2];
#pragma unroll
        for (int bj = 0; bj < 2; ++bj)
#pragma unroll
            for (int n = 0; n < 2; ++n) bv[bj][n] = *(const f32x4*)(bias + col0 + bj * HALF + 4 * n);
#pragma unroll
        for (int ai = 0; ai < 2; ++ai)
#pragma unroll
            for (int m = 0; m < 4; ++m) { const int row = row0 + ai * HALF + m * 16; const float sc = rowscale[row]; bf16_t* rowp = O + (size_t)row * ldc + col0;
#pragma unroll
                for (int bj = 0; bj < 2; ++bj) { const f32x4 v0 = acc[ai][bj][m][0] * sc + bv[bj][0], v1 = acc[ai][bj][m][1] * sc + bv[bj][1];
                    u32x4 w; w.x = cvt_pk_bf16(v0[0], v0[1]); w.y = cvt_pk_bf16(v0[2], v0[3]); w.z = cvt_pk_bf16(v1[0], v1[1]); w.w = cvt_pk_bf16(v1[2], v1[3]);
                    *(u32x4*)(rowp + bj * HALF) = w; } }
    }
};
struct EpiResF32 {
    static constexpr bool PERM = false;
    const float* base; float* C; int ldc;
    __device__ __forceinline__ void operator()(const f32x4 (&acc)[2][2][4][2], const Unit& u, int wr, int wc, int fr, int fq) const {
        const int row0 = u.pm * BM + wr * 64 + fr, col0 = u.pn * BM + wc * 32 + 4 * fq;
#pragma unroll
        for (int ai = 0; ai < 2; ++ai)
#pragma unroll
            for (int m = 0; m < 4; ++m) { const size_t off = (size_t)(row0 + ai * HALF + m * 16) * ldc + col0;
#pragma unroll
                for (int bj = 0; bj < 2; ++bj)
#pragma unroll
                    for (int n = 0; n < 2; ++n) { const f32x4 bs = *(const f32x4*)(base + off + bj * HALF + n * 16); *(f32x4*)(C + off + bj * HALF + n * 16) = bs + acc[ai][bj][m][n]; }
                asm volatile("" ::: "memory"); }
    }
};
struct EpiSwiglu {
    static constexpr bool PERM = true;
    bf16_t* H; const float* lrs;
    __device__ __forceinline__ void operator()(const f32x4 (&acc)[2][2][4][2], const Unit& u, int wr, int wc, int fr, int fq) const {
#pragma unroll
        for (int ai = 0; ai < 2; ++ai)
#pragma unroll
            for (int m = 0; m < 4; ++m) { const int rl = ai * HALF + wr * 64 + m * 16 + fr, idx = u.mt * BM + rl;
                const float sc = idx < u.cnt ? lrs[(size_t)u.e * LCAP + idx] : 0.f;
                bf16_t* rowp = H + (size_t)(u.pm * BM + rl) * DFF + u.pn * HALF + wc * 32 + 8 * fq;
                float hv[8];
#pragma unroll
                for (int n = 0; n < 2; ++n)
#pragma unroll
                    for (int j = 0; j < 4; ++j) { const float g = acc[ai][0][m][n][j] * sc, up = acc[ai][1][m][n][j] * sc; hv[4 * n + j] = g * up / (1.0f + __expf(-g)); }
                u32x4 w; w.x = cvt_pk_bf16(hv[0], hv[1]); w.y = cvt_pk_bf16(hv[2], hv[3]); w.z = cvt_pk_bf16(hv[4], hv[5]); w.w = cvt_pk_bf16(hv[6], hv[7]);
                *(u32x4*)rowp = w; }
    }
};
struct EpiBf16 {
    static constexpr bool PERM = true;
    bf16_t* O; int ldc;
    __device__ __forceinline__ void operator()(const f32x4 (&acc)[2][2][4][2], const Unit& u, int wr, int wc, int fr, int fq) const {
        const int row0 = u.pm * BM + wr * 64 + fr, col0 = u.pn * BM + wc * 32 + 8 * fq;
#pragma unroll
        for (int ai = 0; ai < 2; ++ai)
#pragma unroll
            for (int m = 0; m < 4; ++m) { bf16_t* rowp = O + (size_t)(row0 + ai * HALF + m * 16) * ldc + col0;
#pragma unroll
                for (int bj = 0; bj < 2; ++bj) { const f32x4 v0 = acc[ai][bj][m][0], v1 = acc[ai][bj][m][1];
                    u32x4 w; w.x = cvt_pk_bf16(v0[0], v0[1]); w.y = cvt_pk_bf16(v0[2], v0[3]); w.z = cvt_pk_bf16(v1[0], v1[1]); w.w = cvt_pk_bf16(v1[2], v1[3]);
                    *(u32x4*)(rowp + bj * HALF) = w; } }
    }
};

template <class Epi, class Sched>
__device__ __forceinline__ void gemm_phase(LAS unsigned char* lds, const int K, const Sched& S, const Epi& E) {
    const int tid = threadIdx.x, wid = __builtin_amdgcn_readfirstlane(tid >> 6), lane = tid & 63, wr = wid >> 2, wc = wid & 3, fr = lane & 15, fq = lane >> 4;
    const int nt = K / BK;
    unsigned voffB[2]; unsigned ah[2][2], c1[2];
#pragma unroll
    for (int i = 0; i < 2; ++i) { int R, C; stage_rc(tid * 16 + i * 8192, R, C); const int Rb = Epi::PERM ? ((R & ~31) + perm32(R & 31)) : R;
        voffB[i] = (unsigned)(Rb * K + C) * 2u;
#pragma unroll
        for (int h = 0; h < 2; ++h) ah[h][i] = (unsigned)((R + h * HALF) * K + C) * 2u; }
    const size_t kstep = (size_t)(BK * 2);
    const size_t hstep = (size_t)HALF * K * 2;
    const unsigned ldsw = (unsigned)wid * 1024u;
    const int aoff = lds_byte(wr * 64 + fr, fq * 8), boff = lds_byte(wc * 32 + fr, fq * 8);
#define PG8_SA(b, h) (((b) * 2 + (h)) * HTB)
#define PG8_SB(b, h) ((4 + (b) * 2 + (h)) * HTB)
#define PG8_STAGE(bufoff, gbase, voff) do { _Pragma("unroll") for (int _i = 0; _i < 2; ++_i) \
        __builtin_amdgcn_global_load_lds((const unsigned*)((const char*)(gbase) + (voff)[_i]), (LAS unsigned*)(lds + (bufoff) + ldsw + _i * 8192), 16, 0, 0); } while (0)
#define PG8_LDA(dst, b, h) do { _Pragma("unroll") for (int m = 0; m < 4; ++m) _Pragma("unroll") for (int k = 0; k < 2; ++k) dst[m][k] = *(const LAS bf16x8*)(lds + PG8_SA(b, h) + aoff + m * 2048 + k * 1024); } while (0)
#define PG8_LDB(dst, b, h) do { _Pragma("unroll") for (int n = 0; n < 2; ++n) _Pragma("unroll") for (int k = 0; k < 2; ++k) dst[n][k] = *(const LAS bf16x8*)(lds + PG8_SB(b, h) + boff + n * 2048 + k * 1024); } while (0)
#define PG8_MMA(ai, bj, At, Bt) do { __builtin_amdgcn_s_setprio(1); _Pragma("unroll") for (int m = 0; m < 4; ++m) _Pragma("unroll") for (int n = 0; n < 2; ++n) _Pragma("unroll") for (int k = 0; k < 2; ++k) \
        acc[ai][bj][m][n] = __builtin_amdgcn_mfma_f32_16x16x32_bf16(Bt[n][k], At[m][k], acc[ai][bj][m][n], 0, 0, 0); __builtin_amdgcn_s_setprio(0); } while (0)
#define PG8_WAIT_V(n) asm volatile("s_waitcnt vmcnt(" #n ")" ::: "memory")
#define PG8_WAIT_L(n) asm volatile("s_waitcnt lgkmcnt(" #n ")" ::: "memory")
#define PG8_BAR __builtin_amdgcn_s_barrier()
#define PG8_SCHED __builtin_amdgcn_sched_barrier(0)
    Unit cur, nxt; int ui = 0;
    if (!S.next(0, cur)) return;
    f32x4 acc[2][2][4][2];
#pragma unroll
    for (int a = 0; a < 2; ++a)
#pragma unroll
        for (int b = 0; b < 2; ++b)
#pragma unroll
            for (int m = 0; m < 4; ++m)
#pragma unroll
                for (int n = 0; n < 2; ++n) acc[a][b][m][n] = (f32x4){0.f, 0.f, 0.f, 0.f};
    bf16x8 At[4][2], B0[2][2], B1[2][2];
    const char* cA = cur.a; const char* cB = cur.b;
    if constexpr (Sched::GATHER) { S.a_off(cur, tid, ah); }
    c1[0] = ah[1][0]; c1[1] = ah[1][1];
    PG8_STAGE(PG8_SB(0, 0), cB, voffB); PG8_STAGE(PG8_SB(0, 1), cB + hstep, voffB); PG8_STAGE(PG8_SA(0, 0), cA, ah[0]); PG8_STAGE(PG8_SA(0, 1), cA, ah[1]);
    if (wr == 1) PG8_BAR;
    PG8_WAIT_V(2); PG8_BAR;
    PG8_STAGE(PG8_SB(1, 0), cB + kstep, voffB); PG8_STAGE(PG8_SA(1, 0), cA + kstep, ah[0]); PG8_STAGE(PG8_SB(1, 1), cB + hstep + kstep, voffB);
    PG8_WAIT_V(6); PG8_BAR;
    for (;;) {
        const bool has_next = S.next(ui + 1, nxt);
        const char* nA = has_next ? nxt.a : cA; const char* nB = has_next ? nxt.b : cB;
        for (int t = 0; t < nt; t += 2) {
            const bool last = (t == nt - 2);
            const char* a1 = cA + (size_t)(t + 1) * kstep;
            const char* a2 = last ? nA : cA + (size_t)(t + 2) * kstep; const char* b2 = last ? nB : cB + (size_t)(t + 2) * kstep;
            const char* a3 = a2 + kstep; const char* b3 = b2 + kstep;
            if constexpr (Sched::GATHER) { if (last && has_next) S.a_off(nxt, tid, ah); }
            PG8_LDB(B0, 0, 0); PG8_LDB(B1, 0, 1); PG8_SCHED; PG8_LDA(At, 0, 0); PG8_STAGE(PG8_SA(1, 1), a1, c1);
            PG8_WAIT_V(8); PG8_WAIT_L(0); PG8_BAR; PG8_MMA(0, 0, At, B0); PG8_MMA(0, 1, At, B1); PG8_BAR; PG8_SCHED;
            PG8_LDA(At, 0, 1); PG8_STAGE(PG8_SB(0, 0), b2, voffB); PG8_STAGE(PG8_SB(0, 1), b2 + hstep, voffB); PG8_STAGE(PG8_SA(0, 0), a2, ah[0]);
            PG8_WAIT_V(8); PG8_WAIT_L(0); PG8_BAR; PG8_MMA(1, 0, At, B0); PG8_MMA(1, 1, At, B1); PG8_BAR; PG8_SCHED;
            PG8_LDB(B0, 1, 0); PG8_LDB(B1, 1, 1); PG8_SCHED; PG8_LDA(At, 1, 0); PG8_STAGE(PG8_SA(0, 1), a2, ah[1]);
            PG8_WAIT_V(8); PG8_WAIT_L(0); PG8_BAR; PG8_MMA(0, 0, At, B0); PG8_MMA(0, 1, At, B1); PG8_BAR; PG8_SCHED;
            PG8_LDA(At, 1, 1); PG8_STAGE(PG8_SB(1, 0), b3, voffB); PG8_STAGE(PG8_SB(1, 1), b3 + hstep, voffB); PG8_STAGE(PG8_SA(1, 0), a3, ah[0]);
            PG8_WAIT_V(8); PG8_WAIT_L(0); PG8_BAR; PG8_MMA(1, 0, At, B0); PG8_MMA(1, 1, At, B1); PG8_BAR; PG8_SCHED;
        }
        if (wr == 0) PG8_BAR;
        E(acc, cur, wr, wc, fr, fq);
        if (!has_next) break;
#pragma unroll
        for (int a = 0; a < 2; ++a)
#pragma unroll
            for (int b = 0; b < 2; ++b)
#pragma unroll
                for (int m = 0; m < 4; ++m)
#pragma unroll
                    for (int n = 0; n < 2; ++n) acc[a][b][m][n] = (f32x4){0.f, 0.f, 0.f, 0.f};
        cur = nxt; cA = nA; cB = nB; ++ui;
        c1[0] = ah[1][0]; c1[1] = ah[1][1];
        if (wr == 1) PG8_BAR;
    }
    PG8_WAIT_V(0);
    PG8_BAR;
#undef PG8_SA
#undef PG8_SB
#undef PG8_STAGE
#undef PG8_LDA
#undef PG8_LDB
#undef PG8_MMA
#undef PG8_WAIT_V
#undef PG8_WAIT_L
#undef PG8_BAR
#undef PG8_SCHED
}
}

#define XB_TMO      128
#define XB_XCNT(j)  (256  + 64 * (j))
#define XB_XSUB(j)  (1280 + 64 * (j))
#define XB_XGEN(j)  (2304 + 64 * (j))
#define XB_TOP      3328
#define XB_TOPGEN   3392
#define XCD_BAR_WORDS 3456
#define XB_SPIN_CAP (1u << 18)
__device__ __forceinline__ unsigned xb_ld(unsigned* p)              { return __hip_atomic_load(p, __ATOMIC_RELAXED, __HIP_MEMORY_SCOPE_AGENT); }
__device__ __forceinline__ unsigned xb_add(unsigned* p, unsigned v) { return __hip_atomic_fetch_add(p, v, __ATOMIC_RELAXED, __HIP_MEMORY_SCOPE_AGENT); }
__device__ __forceinline__ unsigned xb_xcc_id() { return (unsigned)__builtin_amdgcn_s_getreg((3 << 11) | 20) & 0xFu; }
#define XB_SPIN(cond, bar) do { unsigned _sp = 0; while (cond) { __builtin_amdgcn_s_sleep(1); \
    if ((++_sp & 255u) == 0u) { if (xb_ld(&(bar)[XB_TMO])) break; if (_sp > XB_SPIN_CAP) { atomicAdd(&(bar)[XB_TMO], 1u); break; } } } } while (0)
struct XcdBarrier { unsigned* bar; unsigned x; volatile LAS unsigned* st; };
__device__ __forceinline__ XcdBarrier xcd_barrier_post(unsigned* bar, volatile LAS unsigned* st) {
    XcdBarrier b; b.bar = bar; b.x = xb_xcc_id(); b.st = st;
    if (threadIdx.x == 0) (void)xb_add(&bar[XB_XCNT(b.x)], 1u);
    return b;
}
__device__ __forceinline__ void xcd_barrier_complete(unsigned* bar, unsigned x, unsigned& nloc, unsigned& nx) {
    const unsigned G = gridDim.x * gridDim.y * gridDim.z;
    unsigned sum, cnt, mine, sp = 0u;
    for (;;) {
        sum = 0u; cnt = 0u; mine = 0u;
#pragma unroll
        for (unsigned j = 0; j < 16; ++j) { const unsigned c = xb_ld(&bar[XB_XCNT(j)]); sum += c; cnt += (c > 0u) ? 1u : 0u; mine = (j == x) ? c : mine; }
        if (sum == G) break;
        __builtin_amdgcn_s_sleep(1);
        if ((++sp & 255u) == 0u) { if (xb_ld(&bar[XB_TMO])) break; if (sp > XB_SPIN_CAP) { atomicAdd(&bar[XB_TMO], 1u); break; } }
    }
    nloc = mine > 0u ? mine : 1u; nx = cnt > 0u ? cnt : 1u;
}
__device__ __forceinline__ void xcd_barrier(const XcdBarrier& b) {
    asm volatile("s_waitcnt vmcnt(0)" ::: "memory");
    __syncthreads();
    if (threadIdx.x == 0) {
        unsigned* bar = b.bar;
        __builtin_amdgcn_s_waitcnt(0);
        unsigned nloc = b.st[0], nx = b.st[1];
        if (nloc == 0u) { xcd_barrier_complete(bar, b.x, nloc, nx); b.st[0] = nloc; b.st[1] = nx; }
        const unsigned old = xb_add(&bar[XB_XSUB(b.x)], 1u);
        const unsigned gen = old / nloc;
        if (old + 1u == (gen + 1u) * nloc) {
            __builtin_amdgcn_fence(__ATOMIC_RELEASE, "agent");
            asm volatile("s_waitcnt vmcnt(0)" ::: "memory");
            const unsigned og = xb_add(&bar[XB_TOP], 1u);
            const unsigned tg = og / nx;
            if (og + 1u == (tg + 1u) * nx) xb_add(&bar[XB_TOPGEN], 1u);
            else XB_SPIN(xb_ld(&bar[XB_TOPGEN]) == tg, bar);
            __builtin_amdgcn_fence(__ATOMIC_ACQUIRE, "agent");
            xb_add(&bar[XB_XGEN(b.x)], 1u);
            asm volatile("s_waitcnt vmcnt(0)" ::: "memory");
        } else {
            XB_SPIN(xb_ld(&bar[XB_XGEN(b.x)]) == gen, bar);
            __builtin_amdgcn_fence(__ATOMIC_ACQUIRE, "agent");
            asm volatile("s_waitcnt vmcnt(0)" ::: "memory");
        }
    }
    __syncthreads();
}

struct Args {
    const float* in[15]; float* out; unsigned char* ws; int ph_lo, ph_hi;
};
struct Frame {
    LAS unsigned char* lds; unsigned* ctl; unsigned char* ws;
    int tid, lane, wave, vcu, G;
};

__device__ __forceinline__ void p0_transpose_item(const float* W, int ldw, int srccol0, const float* ks, float cs, bf16_t* WT, int K, int dstrow0, int k0, LAS float* scr, int lane) {
#pragma unroll 8
    for (int i = 0; i < 32; ++i) { const int kk = 2 * i + (lane >> 5); float v = W[(size_t)(k0 + kk) * ldw + srccol0 + (lane & 31)]; if (ks) v *= ks[k0 + kk]; scr[kk * 33 + (lane & 31)] = v * cs; }
    LDS_WAIT(); asm volatile("" ::: "memory");
    const int c = lane & 7;
#pragma unroll
    for (int j = 0; j < 4; ++j) { const int n = (lane >> 3) + 8 * j; const LAS float* s = scr + (8 * c) * 33 + n;
        u32x4 o; o.x = cvtpk(s[0 * 33], s[1 * 33]); o.y = cvtpk(s[2 * 33], s[3 * 33]); o.z = cvtpk(s[4 * 33], s[5 * 33]); o.w = cvtpk(s[6 * 33], s[7 * 33]);
        *(u32x4*)(WT + (size_t)(dstrow0 + n) * K + k0 + 8 * c) = o; }
    LDS_WAIT(); asm volatile("" ::: "memory");
}

__device__ __forceinline__ void p0_prep(Frame& F, const Args& a) {
    const float* x = a.in[0]; const float* norm_mix = a.in[1]; const float* w_in = a.in[2]; const float* b_in = a.in[3]; const float* w_out = a.in[5];
    const float* norm_ffn = a.in[6]; const float* w_group = a.in[7]; const float* b_group = a.in[8]; const float* w_expert = a.in[9]; const float* b_expert = a.in[10];
    const float* w_gate = a.in[11]; const float* w_up = a.in[12]; const float* w_down = a.in[13];
    bf16_t* WinT = (bf16_t*)(F.ws + WS_WIN); bf16_t* WoutT = (bf16_t*)(F.ws + WS_WOUT); bf16_t* WrT = (bf16_t*)(F.ws + WS_WR);
    float* binp = (float*)(F.ws + WS_WR + 128 * 1024); float* brt = (float*)(F.ws + WS_WR + 160 * 1024);
    bf16_t* W1T = (bf16_t*)(F.ws + WS_W1); bf16_t* W2T = (bf16_t*)(F.ws + WS_W2);
    bf16_t* xb = (bf16_t*)(F.ws + WS_R2); float* rs1 = (float*)(F.ws + WS_RS1); float* gbuf = (float*)(F.ws + WS_GATES);
    LAS float* scr = (LAS float*)(F.lds + F.wave * 8448);
    LAS float* wgs = (LAS float*)(F.lds + 67584);
    const int gw = F.vcu * 8 + F.wave, NGW = F.G * 8, gt = F.vcu * 512 + F.tid, NGT = F.G * 512;
    const float QS = 0.08838834764831845f;
    for (int idx = F.tid; idx < 8192; idx += 512) { const int g = idx >> 10, k = idx & 1023; wgs[idx] = w_in[(size_t)k * NPROJ_IN + 2048 + g] * norm_mix[k]; }
    for (int i = gt; i < NPROJ; i += NGT) { const int col = i < 2048 ? i : i + 8; binp[i] = b_in[col] * (i < 512 ? QS : 1.0f); }
    for (int i = gt; i < 48; i += NGT) brt[i] = i < 4 ? b_group[i] : (i < 36 ? b_expert[i - 4] : 0.f);
    for (int i = gt; i < 48 * 1024; i += NGT) { const int j = i >> 10, k = i & 1023; float v = 0.f; if (j < 4) v = w_group[k * 4 + j]; else if (j < 36) v = w_expert[k * 32 + (j - 4)];
        WrT[i] = (bf16_t)(cvtpk(v * norm_ffn[k], 0.f) & 0xffffu); }
    constexpr int I_IN = 16 * 112, I_OUT = 16 * 32, I_E = 768, NITEMS = I_IN + I_OUT + NE * I_E;
    for (int it = gw; it < NITEMS; it += NGW) {
        int r = it;
        if (r < I_IN) { const int kb = r / 112, nb = r % 112, n0 = 32 * nb; p0_transpose_item(w_in, NPROJ_IN, n0 < 2048 ? n0 : n0 + 8, norm_mix, n0 < 512 ? QS : 1.0f, WinT, 1024, n0, 64 * kb, scr, F.lane); continue; }
        r -= I_IN;
        if (r < I_OUT) { const int kb = r / 32, nb = r % 32; p0_transpose_item(w_out, 1024, 32 * nb, nullptr, 1.0f, WoutT, 1024, 32 * nb, 64 * kb, scr, F.lane); continue; }
        r -= I_OUT;
        const int e = r / I_E; r -= e * I_E;
        if (r < 512) { const int up = r >> 8, rr = r & 255, kb = rr / 16, nb = rr % 16, f0 = 32 * nb;
            p0_transpose_item((up ? w_up : w_gate) + (size_t)e * 1024 * 512, 512, f0, norm_ffn, 1.0f, W1T + (size_t)e * 1024 * 1024, 1024, 256 * (f0 >> 7) + (f0 & 127) + 128 * up, 64 * kb, scr, F.lane); }
        else { const int rr = r - 512, kb = rr / 32, nb = rr % 32; p0_transpose_item(w_down + (size_t)e * 512 * 1024, 1024, 32 * nb, nullptr, 1.0f, W2T + (size_t)e * 1024 * 512, 512, 32 * nb, 64 * kb, scr, F.lane); }
    }
    __syncthreads();
    for (int m = gw; m < NTOK; m += NGW) {
        const f32x4* xr = (const f32x4*)(x + (size_t)m * D) + F.lane;
        f32x4 v[4]; float ss = 0.f;
#pragma unroll
        for (int j = 0; j < 4; ++j) { v[j] = xr[64 * j]; ss += (v[j].x * v[j].x + v[j].y * v[j].y) + (v[j].z * v[j].z + v[j].w * v[j].w); }
        ss = wave_sum(ss);
        const float rs = 1.0f / sqrtf(ss * (1.0f / D) + RMS_EPS);
        u32x2* o8 = (u32x2*)(xb + (size_t)m * D) + F.lane;
#pragma unroll
        for (int j = 0; j < 4; ++j) { u32x2 w; w.x = cvtpk(v[j].x, v[j].y); w.y = cvtpk(v[j].z, v[j].w); o8[64 * j] = w; }
        float val = 0.f;
#pragma unroll
        for (int g = 0; g < 8; ++g) { float d = 0.f;
#pragma unroll
            for (int j = 0; j < 4; ++j) { const f32x4 w = *(const LAS f32x4*)(wgs + g * 1024 + 256 * j + 4 * F.lane); d += (v[j].x * w.x + v[j].y * w.y) + (v[j].z * w.z + v[j].w * w.w); }
            d = wave_sum(d); val = (F.lane == g) ? d : val; }
        if (F.lane < 8) gbuf[(size_t)m * 8 + F.lane] = rs * val + b_in[2048 + F.lane];
        if (F.lane == 0) rs1[m] = rs;
    }
}

constexpr int ML_QS = 0, ML_KS = 17408, ML_VS = 34816, ML_WVS = 39936, ML_OS = 47104, ML_PS = 52224, ML_CS = 61440, ML_CSZ = 13056, ML_VEC = 87552, ML_END = 88576;
constexpr int ML_QSTR = 272, ML_VSTR = 80, ML_WSTR = 112, ML_PSTR = 144;
__device__ __forceinline__ bf16x8 tr_frag(const LAS unsigned char* base, int stride) {
    const s16x4 lo = __builtin_amdgcn_ds_read_tr16_b64_v4i16((LAS s16x4*)(base));
    const s16x4 hi = __builtin_amdgcn_ds_read_tr16_b64_v4i16((LAS s16x4*)(base + 4 * stride));
    return (bf16x8){lo[0], lo[1], lo[2], lo[3], hi[0], hi[1], hi[2], hi[3]};
}
__device__ __forceinline__ u32x4 scale_bf8(u32x4 v, float w) {
    u32x4 o; o.x = cvtpk(bflo(v.x) * w, bfhi(v.x) * w); o.y = cvtpk(bflo(v.y) * w, bfhi(v.y) * w); o.z = cvtpk(bflo(v.z) * w, bfhi(v.z) * w); o.w = cvtpk(bflo(v.w) * w, bfhi(v.w) * w); return o;
}
__device__ __forceinline__ void mlstm_unit(Frame& F, int unit) {
    const bf16_t* proj = (const bf16_t*)(F.ws + WS_R1); const float* gbuf = (const float*)(F.ws + WS_GATES); bf16_t* ymc = (bf16_t*)(F.ws + WS_R2);
    LAS unsigned char* L = F.lds;
    const int b = unit >> 4, h = (unit >> 2) & 3, es = unit & 3;
    const int tid = F.tid, lane = F.lane, wid = F.wave, r = lane & 15, q = lane >> 4;
    for (int i = tid; i < ML_END / 16; i += 512) *(LAS u32x4*)(L + i * 16) = (u32x4){0u, 0u, 0u, 0u};
    const int qrow0 = tid >> 4, qseg = tid & 15;
    const int vrow = (tid & 255) >> 2, vseg = tid & 3;
    const size_t tok0 = (size_t)b * SEQ;
    const bf16_t* pq = proj + (tok0 + qrow0) * NPROJ + h * DH + qseg * 8;
    const bf16_t* pv = proj + (tok0 + vrow) * NPROJ + (tid < 256 ? 1024 : 1536) + h * DH + es * 32 + vseg * 8;
    const float* pg = gbuf + (tok0 + lane) * 8 + h;
    u32x4 rq[2], rk[2], rvo; float rig, rfg;
    rq[0] = *(const u32x4*)pq; rq[1] = *(const u32x4*)(pq + 32 * NPROJ); rk[0] = *(const u32x4*)(pq + 512); rk[1] = *(const u32x4*)(pq + 32 * NPROJ + 512);
    rvo = *(const u32x4*)pv; rig = pg[0]; rfg = pg[4];
    const int t0jt = (wid == 0 || wid == 1 || wid == 3 || wid == 6) ? 0 : ((wid == 2 || wid == 4 || wid == 7) ? 1 : 2);
    const int t0lt = wid == 0 ? 0 : (wid <= 2 ? 1 : (wid <= 5 ? 2 : 3));
    const int t1jt = wid == 0 ? 2 : 3, t1lt = 3; const bool has_t1 = wid < 2;
    const int lt = wid & 3, et = wid >> 2, dt = wid;
    f32x4 accC[3];
#pragma unroll
    for (int i = 0; i < 3; ++i) accC[i] = (f32x4){0.f, 0.f, 0.f, 0.f};
    float m_prev = 0.f;
    LAS float* sv = (LAS float*)(L + ML_VEC); LAS float* Mv = sv + 64; LAS float* wiv = sv + 128; LAS float* emv = sv + 192;
    const bf16x8 ones = (r == 0) ? (bf16x8){16256, 16256, 16256, 16256, 16256, 16256, 16256, 16256} : (bf16x8){0, 0, 0, 0, 0, 0, 0, 0};
    const int trlane = ((lane & 15) >> 2);
    const int trcol = (lane & 3) * 4;
    __syncthreads();
    for (int c = 0; c < NCH; ++c) {
        const float lf = fminf(rfg, 0.f) - log1pf(__expf(-fabsf(rfg)));
        float bc = lf;
#pragma unroll
        for (int o = 1; o < 64; o <<= 1) { const float t = __shfl_up(bc, o); bc = (lane >= o) ? bc + t : bc; }
        const float s = rig - bc; float pmx = s;
#pragma unroll
        for (int o = 1; o < 64; o <<= 1) { const float t = __shfl_up(pmx, o); pmx = (lane >= o) ? fmaxf(pmx, t) : pmx; }
        const float gtot = __shfl(bc, 63);
        const float Ml = fmaxf(m_prev, pmx), M63 = __shfl(Ml, 63);
        const float winter = __expf(m_prev - Ml), emt = __expf(-bc - Ml), wj = __expf(s - M63), decay = __expf(m_prev - M63);
        const float m_next = gtot + M63;
        const float wsel = __shfl(wj, vrow);
        __syncthreads();
        *(LAS u32x4*)(L + ML_QS + qrow0 * ML_QSTR + qseg * 16) = rq[0]; *(LAS u32x4*)(L + ML_QS + (qrow0 + 32) * ML_QSTR + qseg * 16) = rq[1];
        *(LAS u32x4*)(L + ML_KS + qrow0 * ML_QSTR + qseg * 16) = rk[0]; *(LAS u32x4*)(L + ML_KS + (qrow0 + 32) * ML_QSTR + qseg * 16) = rk[1];
        if (tid < 256) { *(LAS u32x4*)(L + ML_VS + vrow * ML_VSTR + vseg * 16) = rvo; *(LAS u32x4*)(L + ML_WVS + vrow * ML_WSTR + vseg * 16) = scale_bf8(rvo, wsel); }
        else *(LAS u32x4*)(L + ML_OS + vrow * ML_VSTR + vseg * 16) = rvo;
        if (wid == 4) *(LAS u32x4*)(L + ML_WVS + lane * ML_WSTR + 64) = (u32x4){cvtpk(wj, 0.f), 0u, 0u, 0u};
        if (wid == 0) { sv[lane] = s; Mv[lane] = Ml; wiv[lane] = winter; emv[lane] = emt; }
        if (c + 1 < NCH) { const size_t adv = (size_t)(c + 1) * CH * NPROJ;
            rq[0] = *(const u32x4*)(pq + adv); rq[1] = *(const u32x4*)(pq + adv + 32 * NPROJ); rk[0] = *(const u32x4*)(pq + adv + 512); rk[1] = *(const u32x4*)(pq + adv + 32 * NPROJ + 512);
            rvo = *(const u32x4*)(pv + adv); rig = pg[(size_t)(c + 1) * CH * 8]; rfg = pg[(size_t)(c + 1) * CH * 8 + 4]; }
        __syncthreads();
#pragma unroll
        for (int ti = 0; ti < 2; ++ti) {
            if (ti == 1 && !has_t1) break;
            const int jt = ti ? t1jt : t0jt, ltt = ti ? t1lt : t0lt;
            f32x4 sacc = (f32x4){0.f, 0.f, 0.f, 0.f};
#pragma unroll
            for (int ds = 0; ds < 4; ++ds) {
                const bf16x8 af = *(const LAS bf16x8*)(L + ML_KS + (16 * jt + r) * ML_QSTR + ds * 64 + q * 16);
                const bf16x8 bfr = *(const LAS bf16x8*)(L + ML_QS + (16 * ltt + r) * ML_QSTR + ds * 64 + q * 16);
                sacc = __builtin_amdgcn_mfma_f32_16x16x32_bf16(af, bfr, sacc, 0, 0, 0);
            }
            const int l = 16 * ltt + r, j0 = 16 * jt + 4 * q; const float Mll = Mv[l]; const f32x4 sj = *(const LAS f32x4*)(sv + j0);
            float p[4];
#pragma unroll
            for (int i = 0; i < 4; ++i) p[i] = (j0 + i <= l) ? sacc[i] * __expf(sj[i] - Mll) : 0.f;
            *(LAS u32x2*)(L + ML_PS + l * ML_PSTR + j0 * 2) = (u32x2){cvtpk(p[0], p[1]), cvtpk(p[2], p[3])};
        }
        {
#pragma unroll
            for (int i = 0; i < 3; ++i) accC[i] = accC[i] * decay;
#pragma unroll
            for (int js = 0; js < 2; ++js) {
                const int jrow = 32 * js + 8 * q + trlane;
                const bf16x8 af = tr_frag(L + ML_KS + jrow * ML_QSTR + (16 * dt + trcol) * 2, ML_QSTR);
#pragma unroll
                for (int e3 = 0; e3 < 3; ++e3) {
                    const bf16x8 bfr = tr_frag(L + ML_WVS + jrow * ML_WSTR + (16 * e3 + trcol) * 2, ML_WSTR);
                    accC[e3] = __builtin_amdgcn_mfma_f32_16x16x32_bf16(af, bfr, accC[e3], 0, 0, 0);
                }
            }
            LAS unsigned char* cs = L + ML_CS + ((c + 1) & 1) * ML_CSZ;
#pragma unroll
            for (int e3 = 0; e3 < 3; ++e3) *(LAS u32x2*)(cs + (16 * e3 + r) * ML_QSTR + (16 * dt + 4 * q) * 2) = (u32x2){cvtpk(accC[e3][0], accC[e3][1]), cvtpk(accC[e3][2], accC[e3][3])};
        }
        __syncthreads();
        {
            const LAS unsigned char* cs = L + ML_CS + (c & 1) * ML_CSZ;
            f32x4 ie = (f32x4){0.f, 0.f, 0.f, 0.f}, id = ie, xe = ie, xd = ie;
#pragma unroll
            for (int js = 0; js < 2; ++js) {
                const bf16x8 bp = *(const LAS bf16x8*)(L + ML_PS + (16 * lt + r) * ML_PSTR + js * 64 + q * 16);
                const bf16x8 av = tr_frag(L + ML_VS + (32 * js + 8 * q + trlane) * ML_VSTR + (16 * et + trcol) * 2, ML_VSTR);
                ie = __builtin_amdgcn_mfma_f32_16x16x32_bf16(av, bp, ie, 0, 0, 0);
                id = __builtin_amdgcn_mfma_f32_16x16x32_bf16(ones, bp, id, 0, 0, 0);
            }
#pragma unroll
            for (int ds = 0; ds < 4; ++ds) {
                const bf16x8 bq = *(const LAS bf16x8*)(L + ML_QS + (16 * lt + r) * ML_QSTR + ds * 64 + q * 16);
                const bf16x8 ac = *(const LAS bf16x8*)(cs + (16 * et + r) * ML_QSTR + ds * 64 + q * 16);
                const bf16x8 an = *(const LAS bf16x8*)(cs + (32 + r) * ML_QSTR + ds * 64 + q * 16);
                xe = __builtin_amdgcn_mfma_f32_16x16x32_bf16(ac, bq, xe, 0, 0, 0);
                xd = __builtin_amdgcn_mfma_f32_16x16x32_bf16(an, bq, xd, 0, 0, 0);
            }
            const int l = 16 * lt + r; const float wl = wiv[l], el = emv[l];
            float den = id[0] + wl * xd[0]; den = __shfl(den, r);
            const float nrm = 1.0f / fmaxf(fabsf(den), el);
            const u32x2 og = *(const LAS u32x2*)(L + ML_OS + l * ML_VSTR + (16 * et + 4 * q) * 2);
            const float o0 = bflo(og.x), o1 = bfhi(og.x), o2 = bflo(og.y), o3 = bfhi(og.y);
            const float y0 = (ie[0] + wl * xe[0]) * nrm / (1.0f + __expf(-o0)), y1 = (ie[1] + wl * xe[1]) * nrm / (1.0f + __expf(-o1));
            const float y2 = (ie[2] + wl * xe[2]) * nrm / (1.0f + __expf(-o2)), y3 = (ie[3] + wl * xe[3]) * nrm / (1.0f + __expf(-o3));
            *(u32x2*)(ymc + (tok0 + (size_t)c * CH + l) * D + h * DH + es * 32 + 16 * et + 4 * q) = (u32x2){cvtpk(y0, y1), cvtpk(y2, y3)};
        }
        m_prev = m_next;
    }
    __syncthreads();
}
__device__ __forceinline__ void conv_part(Frame& F, const float* conv_w, int part) {
    const bf16_t* proj = (const bf16_t*)(F.ws + WS_R1); bf16_t* ymc = (bf16_t*)(F.ws + WS_R2);
    const int cg = F.tid & 63, sub = F.tid >> 6; const int T0 = part * 256 + sub * 32;
    float w0[8], w1[8], w2[8], u1[8], u2[8];
#pragma unroll
    for (int i = 0; i < 8; ++i) { w0[i] = conv_w[8 * cg + i]; w1[i] = conv_w[512 + 8 * cg + i]; w2[i] = conv_w[1024 + 8 * cg + i]; u1[i] = 0.f; u2[i] = 0.f; }
    if ((T0 & (SEQ - 1)) != 0) {
        const bf16_t* p1 = proj + (size_t)(T0 - 1) * NPROJ + 2560 + 8 * cg; const bf16_t* p2 = proj + (size_t)(T0 - 2) * NPROJ + 2560 + 8 * cg;
        const u32x4 c1 = *(const u32x4*)p1, x1 = *(const u32x4*)(p1 + 512), c2 = *(const u32x4*)p2, x2 = *(const u32x4*)(p2 + 512);
#pragma unroll
        for (int i = 0; i < 4; ++i) { u1[2 * i] = bflo(c1[i]) * bflo(x1[i]); u1[2 * i + 1] = bfhi(c1[i]) * bfhi(x1[i]); u2[2 * i] = bflo(c2[i]) * bflo(x2[i]); u2[2 * i + 1] = bfhi(c2[i]) * bfhi(x2[i]); }
    }
#pragma unroll 4
    for (int t = 0; t < 32; ++t) {
        const bf16_t* pp = proj + (size_t)(T0 + t) * NPROJ + 2048 + 8 * cg;
        const u32x4 cb = *(const u32x4*)pp, cc = *(const u32x4*)(pp + 512), cx = *(const u32x4*)(pp + 1024);
        float y[8];
#pragma unroll
        for (int i = 0; i < 4; ++i) {
            const float ua = bflo(cc[i]) * bflo(cx[i]), ub = bfhi(cc[i]) * bfhi(cx[i]);
            y[2 * i] = bflo(cb[i]) * (w0[2 * i] * u2[2 * i] + w1[2 * i] * u1[2 * i] + w2[2 * i] * ua);
            y[2 * i + 1] = bfhi(cb[i]) * (w0[2 * i + 1] * u2[2 * i + 1] + w1[2 * i + 1] * u1[2 * i + 1] + w2[2 * i + 1] * ub);
            u2[2 * i] = u1[2 * i]; u2[2 * i + 1] = u1[2 * i + 1]; u1[2 * i] = ua; u1[2 * i + 1] = ub;
        }
        *(u32x4*)(ymc + (size_t)(T0 + t) * D + 512 + 8 * cg) = (u32x4){cvtpk(y[0], y[1]), cvtpk(y[2], y[3]), cvtpk(y[4], y[5]), cvtpk(y[6], y[7])};
    }
}

constexpr int RT_WSTR = 2064, RT_SCR = 99328, RT_LCNT = 124928, RT_GBASE = 125184, RT_BIAS = 125440;
__device__ __forceinline__ void p4_router(Frame& F, const float* x1) {
    const bf16_t* WrT = (const bf16_t*)(F.ws + WS_WR); const float* brt = (const float*)(F.ws + WS_WR + 160 * 1024);
    bf16_t* x1b = (bf16_t*)(F.ws + WS_R2); int* list = (int*)(F.ws + WS_LIST); float* lrs = (float*)(F.ws + WS_LRS); unsigned* tokinfo = (unsigned*)(F.ws + WS_TOKINFO);
    unsigned* gcnt = F.ctl + CW_CNT;
    LAS unsigned char* L = F.lds; const int tid = F.tid, lane = F.lane, wid = F.wave, r = lane & 15, q = lane >> 4;
    LAS int* lcnt = (LAS int*)(L + RT_LCNT); LAS int* gbase = (LAS int*)(L + RT_GBASE); LAS float* lbias = (LAS float*)(L + RT_BIAS);
    LAS float* scr = (LAS float*)(L + RT_SCR + wid * 3072);
    for (int p = tid; p < 6144; p += 512) { const int row = p >> 7, seg = p & 127; *(LAS u32x4*)(L + row * RT_WSTR + seg * 16) = *(const u32x4*)(WrT + (size_t)p * 8); }
    if (tid < 48) lbias[tid] = brt[tid];
    for (int tile = F.vcu; tile < NTOK / 128; tile += F.G) {
        if (tid < 32) lcnt[tid] = 0;
        __syncthreads();
        const int tokb = tile * 128 + wid * 16;
        f32x4 acc[3]; acc[0] = (f32x4){0.f, 0.f, 0.f, 0.f}; acc[1] = acc[0]; acc[2] = acc[0];
        float ss = 0.f;
        const float* xrow = x1 + (size_t)(tokb + r) * D + 8 * q; bf16_t* brow = x1b + (size_t)(tokb + r) * D + 8 * q;
#pragma unroll 4
        for (int ks = 0; ks < 32; ++ks) {
            const f32x4 a0 = *(const f32x4*)(xrow + 32 * ks), a1 = *(const f32x4*)(xrow + 32 * ks + 4);
            ss += (a0.x * a0.x + a0.y * a0.y) + (a0.z * a0.z + a0.w * a0.w) + (a1.x * a1.x + a1.y * a1.y) + (a1.z * a1.z + a1.w * a1.w);
            const u32x4 pk = (u32x4){cvtpk(a0.x, a0.y), cvtpk(a0.z, a0.w), cvtpk(a1.x, a1.y), cvtpk(a1.z, a1.w)};
            *(u32x4*)(brow + 32 * ks) = pk;
            const bf16x8 af = __builtin_bit_cast(bf16x8, pk);
#pragma unroll
            for (int nt = 0; nt < 3; ++nt) { const bf16x8 bfr = *(const LAS bf16x8*)(L + (16 * nt + r) * RT_WSTR + ks * 64 + q * 16); acc[nt] = __builtin_amdgcn_mfma_f32_16x16x32_bf16(af, bfr, acc[nt], 0, 0, 0); }
        }
        ss += __shfl_xor(ss, 16); ss += __shfl_xor(ss, 32);
        const float rs = 1.0f / sqrtf(ss * (1.0f / D) + RMS_EPS);
#pragma unroll
        for (int nt = 0; nt < 3; ++nt)
#pragma unroll
            for (int i = 0; i < 4; ++i) scr[(4 * q + i) * 48 + 16 * nt + r] = acc[nt][i];
        LDS_WAIT(); asm volatile("" ::: "memory");
        int e0 = 0, e1 = 0, p0 = 0, p1 = 0; float w0 = 0.f, w1 = 0.f;
        if (lane < 16) {
            const LAS float* lg = scr + lane * 48;
            float gl[4];
#pragma unroll
            for (int i = 0; i < 4; ++i) gl[i] = rs * lg[i] + lbias[i];
            int g = 0; float gm = gl[0];
#pragma unroll
            for (int i = 1; i < 4; ++i) if (gl[i] > gm) { gm = gl[i]; g = i; }
            float gs = 0.f;
#pragma unroll
            for (int i = 0; i < 4; ++i) gs += __expf(gl[i] - gm);
            const float pgrp = 1.0f / gs;
            float v0 = -3.0e38f, v1 = -3.0e38f; int i0 = 0, i1 = 0;
#pragma unroll
            for (int i = 0; i < 8; ++i) { const float v = rs * lg[4 + 8 * g + i] + lbias[4 + 8 * g + i];
                if (v > v0) { v1 = v0; i1 = i0; v0 = v; i0 = i; } else if (v > v1) { v1 = v; i1 = i; } }
            const float ex = __expf(v1 - v0); w0 = pgrp / (1.0f + ex); w1 = pgrp * ex / (1.0f + ex);
            e0 = 8 * g + i0; e1 = 8 * g + i1;
            p0 = __hip_atomic_fetch_add(lcnt + e0, 1, __ATOMIC_RELAXED, __HIP_MEMORY_SCOPE_WORKGROUP); p1 = __hip_atomic_fetch_add(lcnt + e1, 1, __ATOMIC_RELAXED, __HIP_MEMORY_SCOPE_WORKGROUP);
        }
        __syncthreads();
        if (tid < 32) { const int n = lcnt[tid]; gbase[tid] = n ? (int)atomicAdd(gcnt + tid, (unsigned)n) : 0; }
        __syncthreads();
        if (lane < 16) {
            const int tok = tokb + lane; p0 += gbase[e0]; p1 += gbase[e1];
            list[(size_t)e0 * LCAP + p0] = tok; list[(size_t)e1 * LCAP + p1] = tok; lrs[(size_t)e0 * LCAP + p0] = rs; lrs[(size_t)e1 * LCAP + p1] = rs;
            *(u32x4*)(tokinfo + (size_t)tok * 8) = (u32x4){(unsigned)e0, (unsigned)p0, __float_as_uint(w0), (unsigned)e1};
            *(u32x4*)(tokinfo + (size_t)tok * 8 + 4) = (u32x4){(unsigned)p1, __float_as_uint(w1), 0u, 0u};
        }
        __syncthreads();
    }
}
__device__ __forceinline__ void moe_tiles(Frame& F) {
    LAS int* tb = (LAS int*)(F.lds + TB_OFF); LAS int* cn = (LAS int*)(F.lds + CNT_OFF);
    __syncthreads();
    if (F.tid < 32) cn[F.tid] = (int)__hip_atomic_load(F.ctl + CW_CNT + F.tid, __ATOMIC_RELAXED, __HIP_MEMORY_SCOPE_AGENT);
    __syncthreads();
    if (F.tid == 0) { int s = 0; for (int e = 0; e < NE; ++e) { tb[e] = s; s += (cn[e] + 255) >> 8; } tb[NE] = s; }
    __syncthreads();
}
__device__ __forceinline__ void p7_final(Frame& F, float* out, const float* gfin) {
    const bf16_t* y2 = (const bf16_t*)(F.ws + WS_Y2); const unsigned* tokinfo = (const unsigned*)(F.ws + WS_TOKINFO);
    const LAS int* tb = (const LAS int*)(F.lds + TB_OFF);
    const int gw = F.vcu * 8 + F.wave, NGW = F.G * 8;
    f32x4 gf[4];
#pragma unroll
    for (int j = 0; j < 4; ++j) gf[j] = ((const f32x4*)gfin)[64 * j + F.lane];
    for (int m = gw; m < NTOK; m += NGW) {
        const u32x4 i0 = *(const u32x4*)(tokinfo + (size_t)m * 8), i1 = *(const u32x4*)(tokinfo + (size_t)m * 8 + 4);
        const int e0 = (int)i0.x, p0 = (int)i0.y, e1 = (int)i0.w, p1 = (int)i1.x; const float w0 = __uint_as_float(i0.z), w1 = __uint_as_float(i1.y);
        const size_t r0 = (size_t)tb[e0] * 256 + p0, r1 = (size_t)tb[e1] * 256 + p1;
        f32x4* xr = (f32x4*)(out + (size_t)m * D) + F.lane;
        const u32x2* ya = (const u32x2*)(y2 + r0 * D) + F.lane; const u32x2* yb = (const u32x2*)(y2 + r1 * D) + F.lane;
        f32x4 v[4]; float ss = 0.f;
#pragma unroll
        for (int j = 0; j < 4; ++j) { const f32x4 xv = xr[64 * j]; const u32x2 a = ya[64 * j], bq = yb[64 * j];
            v[j].x = xv.x + w0 * bflo(a.x) + w1 * bflo(bq.x); v[j].y = xv.y + w0 * bfhi(a.x) + w1 * bfhi(bq.x);
            v[j].z = xv.z + w0 * bflo(a.y) + w1 * bflo(bq.y); v[j].w = xv.w + w0 * bfhi(a.y) + w1 * bfhi(bq.y);
            ss += (v[j].x * v[j].x + v[j].y * v[j].y) + (v[j].z * v[j].z + v[j].w * v[j].w); }
        ss = wave_sum(ss);
        const float rs = 1.0f / sqrtf(ss * (1.0f / D) + RMS_EPS);
#pragma unroll
        for (int j = 0; j < 4; ++j) xr[64 * j] = v[j] * rs * gf[j];
    }
}

constexpr int NPHASE = 8;
__global__ void __launch_bounds__(512, 2) hymba_fwd(Args args) {
    extern __shared__ __attribute__((aligned(16))) unsigned char lds_raw[];
    Frame F;
    F.lds = (LAS unsigned char*)lds_raw; F.ws = args.ws; F.ctl = (unsigned*)(args.ws + WS_CTL);
    F.tid = threadIdx.x; F.lane = F.tid & 63; F.wave = __builtin_amdgcn_readfirstlane(F.tid >> 6);
    F.G = gridDim.x; { const int bx = blockIdx.x; F.vcu = (F.G % 8 == 0) ? (bx % 8) * (F.G / 8) + bx / 8 : bx; }
    for (int u = F.tid; u < (LDS_BYTES - LDSCTL_OFF) / 4; u += 512) ((LAS unsigned*)(F.lds + LDSCTL_OFF))[u] = 0u;
    __syncthreads();
    const int lo = args.ph_lo, hi = args.ph_hi;
    XcdBarrier bar; bar.bar = F.ctl + CW_BAR; bar.x = 0; bar.st = nullptr;
    if (hi - lo > 1) bar = xcd_barrier_post(F.ctl + CW_BAR, (volatile LAS unsigned*)(F.lds + MISC_OFF + 32));
#define IN(k) (lo <= (k) && (k) < hi)
#define SEAM(k) do { if (IN(k) && IN((k) + 1)) xcd_barrier(bar); } while (0)
    float* x1 = args.out;

    if (IN(0)) { p0_prep(F, args); __syncthreads(); }
    SEAM(0);
    if (IN(1)) {
        pg8::DenseOrder S{NTOK / 256, NPROJ / 256, F.G, (int)blockIdx.x, D, (const char*)(F.ws + WS_R2), (const char*)(F.ws + WS_WIN)};
        pg8::EpiProj E{(bf16_t*)(F.ws + WS_R1), NPROJ, (const float*)(F.ws + WS_WR + 128 * 1024), (const float*)(F.ws + WS_RS1)};
        pg8::gemm_phase<pg8::EpiProj, pg8::DenseOrder>(F.lds, D, S, E);
    }
    SEAM(1);
    if (IN(2)) {
        for (int u = F.vcu; u < 256; u += F.G) { if (u < 128) mlstm_unit(F, u); else conv_part(F, args.in[4], u - 128); }
    }
    SEAM(2);
    if (IN(3)) {
        pg8::DenseOrder S{NTOK / 256, D / 256, F.G, (int)blockIdx.x, D, (const char*)(F.ws + WS_R2), (const char*)(F.ws + WS_WOUT)};
        pg8::EpiResF32 E{args.in[0], x1, D};
        pg8::gemm_phase<pg8::EpiResF32, pg8::DenseOrder>(F.lds, D, S, E);
    }
    SEAM(3);
    if (IN(4)) { p4_router(F, x1); }
    SEAM(4);
    if (IN(5)) {
        moe_tiles(F);
        const LAS int* tb = (const LAS int*)(F.lds + TB_OFF); const LAS int* cn = (const LAS int*)(F.lds + CNT_OFF);
        pg8::MoeOrder<true> S{tb[NE], 4, F.G, (int)blockIdx.x, D, (const char*)(F.ws + WS_R2), (const char*)(F.ws + WS_W1), (size_t)1024 * 1024 * 2, (const int*)(F.ws + WS_LIST), tb, cn};
        pg8::EpiSwiglu E{(bf16_t*)(F.ws + WS_HBUF), (const float*)(F.ws + WS_LRS)};
        pg8::gemm_phase<pg8::EpiSwiglu, pg8::MoeOrder<true>>(F.lds, D, S, E);
    }
    SEAM(5);
    if (IN(6)) {
        moe_tiles(F);
        const LAS int* tb = (const LAS int*)(F.lds + TB_OFF); const LAS int* cn = (const LAS int*)(F.lds + CNT_OFF);
        pg8::MoeOrder<false> S{tb[NE], 4, F.G, (int)blockIdx.x, DFF, (const char*)(F.ws + WS_HBUF), (const char*)(F.ws + WS_W2), (size_t)1024 * 512 * 2, nullptr, tb, cn};
        pg8::EpiBf16 E{(bf16_t*)(F.ws + WS_Y2), D};
        pg8::gemm_phase<pg8::EpiBf16, pg8::MoeOrder<false>>(F.lds, DFF, S, E);
    }
    SEAM(6);
    if (IN(7)) { moe_tiles(F); p7_final(F, args.out, args.in[14]); }
#undef IN
#undef SEAM
}

extern "C" void kernel_launch(void* const* d_in, const int* in_sizes, int n_in, void* d_out, int out_size, void* d_ws, size_t ws_size, hipStream_t stream) {
    static int grid = 0;
    if (grid == 0) {
        if (n_in != 15 || in_sizes[0] != NTOK * D || out_size != NTOK * D || ws_size < WS_END) { fprintf(stderr, "kernel_launch: unexpected shapes / workspace (n_in %d, ws %zu)\n", n_in, ws_size); grid = -1; return; }
        int dev = 0, cus = 0;
        if (hipGetDevice(&dev) != hipSuccess || hipDeviceGetAttribute(&cus, hipDeviceAttributeMultiprocessorCount, dev) != hipSuccess) { grid = -1; return; }
        if (hipFuncSetAttribute((const void*)hymba_fwd, hipFuncAttributeMaxDynamicSharedMemorySize, LDS_BYTES) != hipSuccess) { fprintf(stderr, "kernel_launch: hipFuncSetAttribute failed\n"); grid = -1; return; }
        int per_cu = 0;
        (void)hipOccupancyMaxActiveBlocksPerMultiprocessor(&per_cu, (const void*)hymba_fwd, 512, LDS_BYTES);
        (void)hipGetLastError();
        grid = cus;
    }
    if (grid < 0) return;
    (void)hipMemsetAsync((char*)d_ws + WS_CTL, 0, CTL_ZERO_BYTES, stream);
    Args a{};
    for (int i = 0; i < 15; ++i) a.in[i] = (const float*)d_in[i];
    a.out = (float*)d_out; a.ws = (unsigned char*)d_ws;
    if (MK_N_LAUNCHES == 1) { a.ph_lo = 0; a.ph_hi = NPHASE; hipLaunchKernelGGL(hymba_fwd, dim3(grid), dim3(512), LDS_BYTES, stream, a); }
    else for (int p = 0; p < NPHASE; ++p) { a.ph_lo = p; a.ph_hi = p + 1; hipLaunchKernelGGL(hymba_fwd, dim3(grid), dim3(512), LDS_BYTES, stream, a); }
}
```

```cpp
#include <hip/hip_runtime.h>
#include <cstdio>
#include <cstdint>

#ifndef PROBE_PH
#define PROBE_PH -1
#endif
#ifndef MK_N_LAUNCHES
#define MK_N_LAUNCHES 1
#endif

#define LAS __attribute__((address_space(3)))
#define GAS __attribute__((address_space(1)))
typedef unsigned short bf16_t;
typedef short bf16x8 __attribute__((ext_vector_type(8)));
typedef short s16x4 __attribute__((ext_vector_type(4)));
typedef float f32x4 __attribute__((ext_vector_type(4)));
typedef float f32x2 __attribute__((ext_vector_type(2)));
typedef unsigned u32x4 __attribute__((ext_vector_type(4)));
typedef unsigned u32x2 __attribute__((ext_vector_type(2)));
typedef int i32x8 __attribute__((ext_vector_type(8)));
typedef int i32x4 __attribute__((ext_vector_type(4)));
constexpr int FP8_W_SHIFT = 5, FP8_H_SHIFT = 3, FP8_Y_SHIFT = 3;

constexpr int NTOK = 32768, D = 1024, SEQ = 4096;
constexpr int NH = 4, DH = 128, CH = 64, NCH = SEQ / CH;
constexpr int NPROJ = 3584, NPROJ_IN = 3592;
constexpr int NE = 32, DFF = 512, LCAP = 32768;
constexpr int MAXTILES = 288;
constexpr float RMS_EPS = 1e-6f;

constexpr size_t MiB = 1u << 20;
constexpr size_t WS_CTL = 0, CTL_ZERO_BYTES = 64 * 1024;
constexpr size_t WS_WIN = 2 * MiB;
constexpr size_t WS_WOUT = 9 * MiB;
constexpr size_t WS_WR = 11 * MiB;
constexpr size_t WS_W1 = 12 * MiB;
constexpr size_t WS_W2 = 76 * MiB;
constexpr size_t WS_LIST = 108 * MiB;
constexpr size_t WS_LRS = 112 * MiB;
constexpr size_t WS_TOKINFO = 116 * MiB;
constexpr size_t WS_RS1 = 117 * MiB;
constexpr size_t WS_GATES = 118 * MiB;
constexpr size_t WS_R2 = 120 * MiB;
constexpr size_t WS_YMC = 44 * MiB;
constexpr size_t WS_R1 = 184 * MiB;
constexpr size_t WS_HBUF = WS_R1, WS_Y2 = WS_R1 + 72 * MiB;
constexpr size_t WS_X1B = 408 * MiB;
constexpr size_t WS_GSC = 472 * MiB;
constexpr size_t WS_X1Q = 44 * MiB;
constexpr size_t WS_END = 480 * MiB;
constexpr int CW_CNT = 64;
constexpr int CW_QUEUE = 128;
constexpr int CW_QUEUE2 = 192;
constexpr int CW_BAR = 4096;
constexpr int CW_DEP_QK = 16, CW_DEP_CV = 48;

constexpr int RING_BYTES = 131072;
constexpr int LDSCTL_OFF = 143360, MISC_OFF = LDSCTL_OFF + 320, TB_OFF = LDSCTL_OFF + 1024, CNT_OFF = LDSCTL_OFF + 1280;
constexpr int LDS_BYTES = 147456;

typedef __bf16 bf16pair_t __attribute__((ext_vector_type(2)));
__device__ __forceinline__ unsigned cvtpk(float lo, float hi) { bf16pair_t v; v[0] = (__bf16)lo; v[1] = (__bf16)hi; return __builtin_bit_cast(unsigned, v); }
__device__ __forceinline__ float bflo(unsigned u) { return __uint_as_float(u << 16); }
__device__ __forceinline__ float bfhi(unsigned u) { return __uint_as_float(u & 0xffff0000u); }
__device__ __forceinline__ float wave_sum(float v) {
#pragma unroll
    for (int o = 1; o < 64; o <<= 1) v += __shfl_xor(v, o);
    return v;
}
#define LDS_WAIT() asm volatile("s_waitcnt lgkmcnt(0)" ::: "memory")

namespace pg8 {
constexpr int NTOK_TILES = 128;
constexpr int BM = 256, BK = 64, HALF = 128, HTB = HALF * BK * 2, STAGE_BYTES = 8 * HTB, NXCD = 8, WGM = 8;
__host__ __device__ __forceinline__ int lds_byte(int r, int c) { const int st = (r >> 4) * 2 + (c >> 5), rr = r & 15, cc = c & 31, ob = rr * 64 + cc * 2; return st * 1024 + (ob ^ (((ob >> 9) & 1) << 5)); }
__host__ __device__ __forceinline__ void stage_rc(int b, int& R, int& C) { const int st = b / 1024, sb = b % 1024, swz = sb ^ (((sb >> 9) & 1) << 5); R = (st >> 1) * 16 + swz / 64; C = (st & 1) * 32 + (swz % 64) / 2; }
__host__ __device__ __forceinline__ int perm32(int rho) { const int n = rho >> 4, i = rho & 15; return 8 * (i >> 2) + 4 * n + (i & 3); }

struct Unit { int pm, pn; const char* a; const char* b; int e, mt, cnt; };

__device__ __forceinline__ void tile_of(int L, int nM, int nN, int& pm, int& pn) {
    const int nwg = nM * nN; int wgid = L;
    { const int q = nwg / NXCD, r = nwg % NXCD, xcd = wgid % NXCD, off = wgid / NXCD; wgid = (xcd < r ? xcd * (q + 1) : r * (q + 1) + (xcd - r) * q) + off; }
    const int nig = WGM * nN, gid = wgid / nig, fm = gid * WGM, gsz = (nM - fm) < WGM ? (nM - fm) : WGM;
    pm = fm + ((wgid % nig) % gsz); pn = (wgid % nig) / gsz;
}
struct DenseOrder {
    static constexpr bool GATHER = false, FP8 = false; static constexpr int sA = 0, sB = 0;
    int nM, nN, G, c, K; const char* A; const char* B; int lda, ldb;
    __device__ __forceinline__ bool next(int i, Unit& u) const {
        const long L = (long)i * G + c; if (L >= (long)nM * nN) return false;
        tile_of((int)L, nM, nN, u.pm, u.pn);
        u.a = A + (size_t)u.pm * BM * lda * 2; u.b = B + (size_t)u.pn * BM * ldb * 2; u.e = 0; u.mt = 0; u.cnt = 0; return true;
    }
    __device__ __forceinline__ void a_off(const Unit&, int, unsigned (&)[2][2]) const {}
};
struct ProjOrder {
    static constexpr bool GATHER = false, FP8 = false; static constexpr int sA = 0, sB = 0;
    int pass, c; const char* A; const char* B; int lda, ldb;
    __device__ __forceinline__ bool next(int i, Unit& u) const {
        if (pass == 0) { if (i >= 4) return false; tile_of(i * 256 + c, NTOK_TILES, 8, u.pm, u.pn); }
        else { if (i >= 3) return false; tile_of(i * 256 + c, NTOK_TILES, 6, u.pm, u.pn); u.pn += 8; }
        u.a = A + (size_t)u.pm * BM * lda * 2; u.b = B + (size_t)u.pn * BM * ldb * 2; u.e = 0; u.mt = 0; u.cnt = 0; return true;
    }
    __device__ __forceinline__ void a_off(const Unit&, int, unsigned (&)[2][2]) const {}
};
template <bool GATHER_>
struct MoeOrder {
    static constexpr bool GATHER = GATHER_, FP8 = true;
    int nM, nN, G, c, K; const char* A; const char* B; size_t b_estride; const int* list; const LAS int* tb; const LAS int* cn; int lda, ldb, sA, sB;
    __device__ __forceinline__ bool next(int i, Unit& u) const {
        const long L = (long)i * G + c; if (L >= (long)nM * nN) return false;
        tile_of((int)L, nM, nN, u.pm, u.pn);
        int e = 0;
#pragma unroll
        for (int j = 1; j < NE; ++j) e += (tb[j] <= u.pm) ? 1 : 0;
        e = __builtin_amdgcn_readfirstlane(e);
        u.e = e; u.mt = u.pm - __builtin_amdgcn_readfirstlane(tb[e]); u.cnt = __builtin_amdgcn_readfirstlane(cn[e]);
        u.b = B + (size_t)e * b_estride + (size_t)u.pn * BM * ldb * 2;
        u.a = GATHER ? A : A + (size_t)u.pm * BM * lda * 2; return true;
    }
    __device__ __forceinline__ void a_off(const Unit& u, int tid, unsigned (&off)[2][2]) const {
        if constexpr (GATHER) {
            asm volatile("" : "+v"(tid));
#pragma unroll
            for (int i = 0; i < 2; ++i) { int R, C; stage_rc(tid * 16 + i * 8192, R, C);
#pragma unroll
                for (int h = 0; h < 2; ++h) { int idx = u.mt * BM + R + h * HALF; idx = idx < u.cnt ? idx : u.mt * BM; const int tok = list[(size_t)u.e * LCAP + idx];
                    off[h][i] = (unsigned)tok * (unsigned)(lda * 2) + (unsigned)C * 2u; } }
        }
    }
};

__device__ __forceinline__ unsigned cvt_pk_bf16(float lo, float hi) { return cvtpk(lo, hi); }

struct EpiProj {
    static constexpr bool PERM = true;
    bf16_t* O; int ldc; const float* bias; const float* rowscale;
    __device__ __forceinline__ void operator()(const f32x4 (&acc)[2][2][4][2], const Unit& u, int wr, int wc, int fr, int fq) const {
        asm volatile("" : "+v"(fr));
        const int row0 = u.pm * BM + wr * 64 + fr, col0 = u.pn * BM + wc * 32 + 8 * fq;
        f32x4 bv[2][2];
#pragma unroll
        for (int bj = 0; bj < 2; ++bj)
#pragma unroll
            for (int n = 0; n < 2; ++n) bv[bj][n] = *(const f32x4*)(bias + col0 + bj * HALF + 4 * n);
#pragma unroll
        for (int ai = 0; ai < 2; ++ai)
#pragma unroll
            for (int m = 0; m < 4; ++m) { const int row = row0 + ai * HALF + m * 16; const float sc = rowscale[row]; bf16_t* rowp = O + (size_t)row * ldc + col0;
#pragma unroll
                for (int bj = 0; bj < 2; ++bj) { const f32x4 v0 = acc[ai][bj][m][0] * sc + bv[bj][0], v1 = acc[ai][bj][m][1] * sc + bv[bj][1];
                    u32x4 w; w.x = cvt_pk_bf16(v0[0], v0[1]); w.y = cvt_pk_bf16(v0[2], v0[3]); w.z = cvt_pk_bf16(v1[0], v1[1]); w.w = cvt_pk_bf16(v1[2], v1[3]);
                    *(u32x4*)(rowp + bj * HALF) = w; } }
    }
};
struct EpiResBf16 {
    static constexpr bool PERM = true;
    const float* base; bf16_t* O; int ldc;
    __device__ __forceinline__ void operator()(const f32x4 (&acc)[2][2][4][2], const Unit& u, int wr, int wc, int fr, int fq) const {
        asm volatile("" : "+v"(fr));
        const int row0 = u.pm * BM + wr * 64 + fr, col0 = u.pn * BM + wc * 32 + 8 * fq;
#pragma unroll
        for (int ai = 0; ai < 2; ++ai)
#pragma unroll
            for (int m = 0; m < 4; ++m) { const size_t off = (size_t)(row0 + ai * HALF + m * 16) * ldc + col0;
#pragma unroll
                for (int bj = 0; bj < 2; ++bj) { const f32x4 b0 = *(const f32x4*)(base + off + bj * HALF), b1 = *(const f32x4*)(base + off + bj * HALF + 4);
                    const f32x4 v0 = acc[ai][bj][m][0] + b0, v1 = acc[ai][bj][m][1] + b1;
                    u32x4 w; w.x = cvt_pk_bf16(v0[0], v0[1]); w.y = cvt_pk_bf16(v0[2], v0[3]); w.z = cvt_pk_bf16(v1[0], v1[1]); w.w = cvt_pk_bf16(v1[2], v1[3]);
                    *(u32x4*)(O + off + bj * HALF) = w; } }
    }
};
struct EpiAddBf16 {
    static constexpr bool PERM = true;
    const bf16_t* base; bf16_t* O; int ldc;
    __device__ __forceinline__ void operator()(const f32x4 (&acc)[2][2][4][2], const Unit& u, int wr, int wc, int fr, int fq) const {
        asm volatile("" : "+v"(fr));
        const int row0 = u.pm * BM + wr * 64 + fr, col0 = u.pn * BM + wc * 32 + 8 * fq;
#pragma unroll
        for (int ai = 0; ai < 2; ++ai)
#pragma unroll
            for (int m = 0; m < 4; ++m) { const size_t off = (size_t)(row0 + ai * HALF + m * 16) * ldc + col0;
#pragma unroll
                for (int bj = 0; bj < 2; ++bj) { const u32x4 b = *(const u32x4*)(base + off + bj * HALF);
                    const f32x4 v0 = acc[ai][bj][m][0], v1 = acc[ai][bj][m][1];
                    u32x4 w; w.x = cvt_pk_bf16(v0[0] + bflo(b.x), v0[1] + bfhi(b.x)); w.y = cvt_pk_bf16(v0[2] + bflo(b.y), v0[3] + bfhi(b.y));
                    w.z = cvt_pk_bf16(v1[0] + bflo(b.z), v1[1] + bfhi(b.z)); w.w = cvt_pk_bf16(v1[2] + bflo(b.w), v1[3] + bfhi(b.w));
                    *(u32x4*)(O + off + bj * HALF) = w; } }
    }
};
struct EpiSwiglu {
    static constexpr bool PERM = true;
    unsigned char* H; const float* lrs;
    __device__ __forceinline__ void operator()(const f32x4 (&acc)[2][2][4][2], const Unit& u, int wr, int wc, int fr, int fq) const {
        asm volatile("" : "+v"(fr));
        float scv[2][4];
#pragma unroll
        for (int ai = 0; ai < 2; ++ai)
#pragma unroll
            for (int m = 0; m < 4; ++m) { const int idx = u.mt * BM + ai * HALF + wr * 64 + m * 16 + fr; scv[ai][m] = lrs[(size_t)u.e * LCAP + (idx < u.cnt ? idx : u.mt * BM)]; }
#pragma unroll
        for (int ai = 0; ai < 2; ++ai)
#pragma unroll
            for (int m = 0; m < 4; ++m) { const int rl = ai * HALF + wr * 64 + m * 16 + fr;
                const float sc = scv[ai][m], nsc = sc * -1.4426950408889634f, sc3 = sc * sc * (float)(1 << FP8_H_SHIFT);
                unsigned char* rowp = H + (size_t)(u.pm * BM + rl) * DFF + u.pn * HALF + wc * 32 + 8 * fq;
                f32x4 hv[2];
#pragma unroll
                for (int n = 0; n < 2; ++n) { const f32x4 ag = acc[ai][0][m][n], au = acc[ai][1][m][n]; const f32x4 t = ag * nsc; f32x4 d;
#pragma unroll
                    for (int j = 0; j < 4; ++j) d[j] = __builtin_amdgcn_exp2f(t[j]);
                    d = d + 1.0f;
#pragma unroll
                    for (int j = 0; j < 4; ++j) d[j] = __builtin_amdgcn_rcpf(d[j]);
                    hv[n] = (ag * au) * sc3 * d; }
                u32x2 w;
                w.x = (unsigned)__builtin_amdgcn_cvt_pk_fp8_f32(hv[0][0], hv[0][1], 0, false); w.x = (unsigned)__builtin_amdgcn_cvt_pk_fp8_f32(hv[0][2], hv[0][3], (int)w.x, true);
                w.y = (unsigned)__builtin_amdgcn_cvt_pk_fp8_f32(hv[1][0], hv[1][1], 0, false); w.y = (unsigned)__builtin_amdgcn_cvt_pk_fp8_f32(hv[1][2], hv[1][3], (int)w.y, true);
                *(u32x2*)rowp = w; }
    }
};
struct EpiFp8 {
    static constexpr int PERM = 2;
    unsigned char* O; int ldc;
    __device__ __forceinline__ void operator()(const f32x4 (&acc)[2][2][4][2], const Unit& u, int wr, int wc, int fr, int fq) const {
        asm volatile("" : "+v"(fr));
        const int row0 = u.pm * BM + wr * 64 + fr, col0 = u.pn * BM + wc * 64 + 16 * fq; const float ys = (float)(1 << FP8_Y_SHIFT);
#pragma unroll
        for (int ai = 0; ai < 2; ++ai)
#pragma unroll
            for (int m = 0; m < 4; ++m) { unsigned char* rowp = O + (size_t)(row0 + ai * HALF + m * 16) * ldc + col0;
                unsigned wv[4];
#pragma unroll
                for (int bj = 0; bj < 2; ++bj)
#pragma unroll
                    for (int n = 0; n < 2; ++n) { const f32x4 v = acc[ai][bj][m][n] * ys;
                        unsigned w = (unsigned)__builtin_amdgcn_cvt_pk_fp8_f32(v[0], v[1], 0, false); w = (unsigned)__builtin_amdgcn_cvt_pk_fp8_f32(v[2], v[3], (int)w, true); wv[bj * 2 + n] = w; }
                *(u32x4*)rowp = (u32x4){wv[0], wv[1], wv[2], wv[3]}; }
    }
};
struct EpiBf16 {
    static constexpr bool PERM = true;
    bf16_t* O; int ldc;
    __device__ __forceinline__ void operator()(const f32x4 (&acc)[2][2][4][2], const Unit& u, int wr, int wc, int fr, int fq) const {
        asm volatile("" : "+v"(fr));
        const int row0 = u.pm * BM + wr * 64 + fr, col0 = u.pn * BM + wc * 32 + 8 * fq;
#pragma unroll
        for (int ai = 0; ai < 2; ++ai)
#pragma unroll
            for (int m = 0; m < 4; ++m) { bf16_t* rowp = O + (size_t)(row0 + ai * HALF + m * 16) * ldc + col0;
#pragma unroll
                for (int bj = 0; bj < 2; ++bj) { const f32x4 v0 = acc[ai][bj][m][0], v1 = acc[ai][bj][m][1];
                    u32x4 w; w.x = cvt_pk_bf16(v0[0], v0[1]); w.y = cvt_pk_bf16(v0[2], v0[3]); w.z = cvt_pk_bf16(v1[0], v1[1]); w.w = cvt_pk_bf16(v1[2], v1[3]);
                    *(u32x4*)(rowp + bj * HALF) = w; } }
    }
};

template <class Epi, class Sched>
__device__ __forceinline__ void gemm_phase(LAS unsigned char* lds, const int K, const Sched& S, const Epi& E) {
    const int tid = threadIdx.x, wid = __builtin_amdgcn_readfirstlane(tid >> 6), lane = tid & 63, wr = wid >> 2, wc = wid & 3, fr = lane & 15, fq = lane >> 4;
    const int nt = K / BK;
    unsigned voffB[2]; unsigned ah[2][2], c1[2];
#pragma unroll
    for (int i = 0; i < 2; ++i) { int R, C; stage_rc(tid * 16 + i * 8192, R, C); const int Rb = (int)Epi::PERM == 2 ? (64 * (R >> 5) + 16 * ((R >> 2) & 3) + 4 * ((R >> 4) & 1) + (R & 3)) : Epi::PERM ? ((R & ~31) + perm32(R & 31)) : R;
        voffB[i] = (unsigned)(Rb * S.ldb + C) * 2u;
#pragma unroll
        for (int h = 0; h < 2; ++h) ah[h][i] = (unsigned)((R + h * HALF) * S.lda + C) * 2u; }
    const size_t kstep = (size_t)(BK * 2);
    const size_t hstep = (size_t)((int)Epi::PERM == 2 ? 8 : HALF) * S.ldb * 2;
    const unsigned ldsw = (unsigned)wid * 1024u;
    const int aoff = lds_byte(wr * 64 + fr, fq * 8), boff = lds_byte(wc * 32 + fr, fq * 8);
#define PG8_SA(b, h) (((b) * 2 + (h)) * HTB)
#define PG8_SB(b, h) ((4 + (b) * 2 + (h)) * HTB)
#define PG8_STAGE(bufoff, gbase, voff) do { _Pragma("unroll") for (int _i = 0; _i < 2; ++_i) \
        __builtin_amdgcn_global_load_lds((const unsigned*)((const char*)(gbase) + (voff)[_i]), (LAS unsigned*)(lds + (bufoff) + ldsw + _i * 8192), 16, 0, 0); } while (0)
#define PG8_LD16(off) (*(const LAS bf16x8*)(lds + (off)))
#define PG8_LD8(off) (*(const LAS i32x4*)(lds + (off)))
#define PG8_LDA(dst, b, h) do { _Pragma("unroll") for (int m = 0; m < 4; ++m) { if constexpr (Sched::FP8) { const i32x4 lo_ = PG8_LD8(PG8_SA(b, h) + aoff + m * 2048), hi_ = PG8_LD8(PG8_SA(b, h) + aoff + m * 2048 + 1024); \
            dst##8[m] = (i32x8){lo_[0], lo_[1], lo_[2], lo_[3], hi_[0], hi_[1], hi_[2], hi_[3]}; } else { _Pragma("unroll") for (int k = 0; k < 2; ++k) dst[m][k] = PG8_LD16(PG8_SA(b, h) + aoff + m * 2048 + k * 1024); } } } while (0)
#define PG8_LDB(dst, b, h) do { _Pragma("unroll") for (int n = 0; n < 2; ++n) { if constexpr (Sched::FP8) { const i32x4 lo_ = PG8_LD8(PG8_SB(b, h) + boff + n * 2048), hi_ = PG8_LD8(PG8_SB(b, h) + boff + n * 2048 + 1024); \
            dst##8[n] = (i32x8){lo_[0], lo_[1], lo_[2], lo_[3], hi_[0], hi_[1], hi_[2], hi_[3]}; } else { _Pragma("unroll") for (int k = 0; k < 2; ++k) dst[n][k] = PG8_LD16(PG8_SB(b, h) + boff + n * 2048 + k * 1024); } } } while (0)
#define PG8_MMA16(ai, bj, At, Bt) do { __builtin_amdgcn_s_setprio(1); _Pragma("unroll") for (int m = 0; m < 4; ++m) _Pragma("unroll") for (int n = 0; n < 2; ++n) _Pragma("unroll") for (int k = 0; k < 2; ++k) \
        acc[ai][bj][m][n] = __builtin_amdgcn_mfma_f32_16x16x32_bf16(Bt[n][k], At[m][k], acc[ai][bj][m][n], 0, 0, 0); __builtin_amdgcn_s_setprio(0); } while (0)
#define PG8_MMA8(ai, bj, At, Bt) do { __builtin_amdgcn_s_setprio(1); _Pragma("unroll") for (int m = 0; m < 4; ++m) _Pragma("unroll") for (int n = 0; n < 2; ++n) \
        asm volatile("v_mfma_scale_f32_16x16x128_f8f6f4 %0, %1, %2, %0, %3, %3 op_sel:[0,1,0] op_sel_hi:[0,0,0]" : "+v"(acc[ai][bj][m][n]) : "v"(Bt##8[n]), "v"(At##8[m]), "v"(scv)); __builtin_amdgcn_s_setprio(0); } while (0)
#define PG8_MMA(ai, bj, At, Bt) do { if constexpr (Sched::FP8) PG8_MMA8(ai, bj, At, Bt); else PG8_MMA16(ai, bj, At, Bt); } while (0)
#define PG8_WAIT_V(n) asm volatile("s_waitcnt vmcnt(" #n ")" ::: "memory")
#define PG8_WAIT_L(n) asm volatile("s_waitcnt lgkmcnt(" #n ")" ::: "memory")
#define PG8_BAR __builtin_amdgcn_s_barrier()
#define PG8_SCHED __builtin_amdgcn_sched_barrier(0)
    Unit cur, nxt; int ui = 0;
    if (!S.next(0, cur)) return;
    f32x4 acc[2][2][4][2];
#pragma unroll
    for (int a = 0; a < 2; ++a)
#pragma unroll
        for (int b = 0; b < 2; ++b)
#pragma unroll
            for (int m = 0; m < 4; ++m)
#pragma unroll
                for (int n = 0; n < 2; ++n) acc[a][b][m][n] = (f32x4){0.f, 0.f, 0.f, 0.f};
    const int scv = (S.sB & 0xff) | ((S.sA & 0xff) << 8);
    bf16x8 At[4][2], B0[2][2], B1[2][2]; i32x8 At8[4], B08[2], B18[2];
    const char* cA = cur.a; const char* cB = cur.b;
    if constexpr (Sched::GATHER) { S.a_off(cur, tid, ah); }
    c1[0] = ah[1][0]; c1[1] = ah[1][1];
    PG8_STAGE(PG8_SB(0, 0), cB, voffB); PG8_STAGE(PG8_SB(0, 1), cB + hstep, voffB); PG8_STAGE(PG8_SA(0, 0), cA, ah[0]); PG8_STAGE(PG8_SA(0, 1), cA, ah[1]);
    if (wr == 1) PG8_BAR;
    PG8_WAIT_V(2); PG8_BAR;
    PG8_STAGE(PG8_SB(1, 0), cB + kstep, voffB); PG8_STAGE(PG8_SA(1, 0), cA + kstep, ah[0]); PG8_STAGE(PG8_SB(1, 1), cB + hstep + kstep, voffB);
    PG8_WAIT_V(6); PG8_BAR;
    for (;;) {
        const bool has_next = S.next(ui + 1, nxt);
        const char* nA = has_next ? nxt.a : cA; const char* nB = has_next ? nxt.b : cB;
        for (int t = 0; t < nt; t += 2) {
            const bool last = (t == nt - 2);
            const char* a1 = cA + (size_t)(t + 1) * kstep;
            const char* a2 = last ? nA : cA + (size_t)(t + 2) * kstep; const char* b2 = last ? nB : cB + (size_t)(t + 2) * kstep;
            const char* a3 = a2 + kstep; const char* b3 = b2 + kstep;
            if constexpr (Sched::GATHER) { if (last && has_next) S.a_off(nxt, tid, ah); }
            PG8_LDB(B0, 0, 0); PG8_LDB(B1, 0, 1); PG8_SCHED; PG8_LDA(At, 0, 0); PG8_STAGE(PG8_SA(1, 1), a1, c1);
            PG8_WAIT_V(8); PG8_WAIT_L(0); PG8_BAR; PG8_MMA(0, 0, At, B0); PG8_MMA(0, 1, At, B1); PG8_BAR; PG8_SCHED;
            PG8_LDA(At, 0, 1); PG8_STAGE(PG8_SB(0, 0), b2, voffB); PG8_STAGE(PG8_SB(0, 1), b2 + hstep, voffB); PG8_STAGE(PG8_SA(0, 0), a2, ah[0]);
            PG8_WAIT_V(8); PG8_WAIT_L(0); PG8_BAR; PG8_MMA(1, 0, At, B0); PG8_MMA(1, 1, At, B1); PG8_BAR; PG8_SCHED;
            PG8_LDB(B0, 1, 0); PG8_LDB(B1, 1, 1); PG8_SCHED; PG8_LDA(At, 1, 0); PG8_STAGE(PG8_SA(0, 1), a2, ah[1]);
            PG8_WAIT_V(8); PG8_WAIT_L(0); PG8_BAR; PG8_MMA(0, 0, At, B0); PG8_MMA(0, 1, At, B1); PG8_BAR; PG8_SCHED;
            PG8_LDA(At, 1, 1); PG8_STAGE(PG8_SB(1, 0), b3, voffB); PG8_STAGE(PG8_SB(1, 1), b3 + hstep, voffB); PG8_STAGE(PG8_SA(1, 0), a3, ah[0]);
            PG8_WAIT_V(8); PG8_WAIT_L(0); PG8_BAR; PG8_MMA(1, 0, At, B0); PG8_MMA(1, 1, At, B1); PG8_BAR; PG8_SCHED;
        }
        if constexpr (Sched::FP8) asm volatile("s_nop 15\n\ts_nop 15" ::: "memory");
        if (wr == 0) PG8_BAR;
        E(acc, cur, wr, wc, fr, fq);
        if (!has_next) break;
#pragma unroll
        for (int a = 0; a < 2; ++a)
#pragma unroll
            for (int b = 0; b < 2; ++b)
#pragma unroll
                for (int m = 0; m < 4; ++m)
#pragma unroll
                    for (int n = 0; n < 2; ++n) acc[a][b][m][n] = (f32x4){0.f, 0.f, 0.f, 0.f};
        cur = nxt; cA = nA; cB = nB; ++ui;
        c1[0] = ah[1][0]; c1[1] = ah[1][1];
        if (wr == 1) PG8_BAR;
    }
    PG8_WAIT_V(0);
    PG8_BAR;
#undef PG8_SA
#undef PG8_SB
#undef PG8_STAGE
#undef PG8_LDA
#undef PG8_LD16
#undef PG8_LD8
#undef PG8_MMA16
#undef PG8_MMA8
#undef PG8_LDB
#undef PG8_MMA
#undef PG8_WAIT_V
#undef PG8_WAIT_L
#undef PG8_BAR
#undef PG8_SCHED
}
}

#define XB_TMO      128
#define XB_XCNT(j)  (256  + 64 * (j))
#define XB_XSUB(j)  (1280 + 64 * (j))
#define XB_XGEN(j)  (2304 + 64 * (j))
#define XB_TOP      3328
#define XB_TOPGEN   3392
#define XCD_BAR_WORDS 3456
#define XB_SPIN_CAP (1u << 18)
__device__ __forceinline__ unsigned xb_ld(unsigned* p)              { return __hip_atomic_load(p, __ATOMIC_RELAXED, __HIP_MEMORY_SCOPE_AGENT); }
__device__ __forceinline__ unsigned xb_add(unsigned* p, unsigned v) { return __hip_atomic_fetch_add(p, v, __ATOMIC_RELAXED, __HIP_MEMORY_SCOPE_AGENT); }
__device__ __forceinline__ unsigned xb_xcc_id() { return (unsigned)__builtin_amdgcn_s_getreg((3 << 11) | 20) & 0xFu; }
#define XB_SPIN(cond, bar) do { unsigned _sp = 0; while (cond) { __builtin_amdgcn_s_sleep(1); \
    if ((++_sp & 255u) == 0u) { if (xb_ld(&(bar)[XB_TMO])) break; if (_sp > XB_SPIN_CAP) { atomicAdd(&(bar)[XB_TMO], 1u); break; } } } } while (0)
struct XcdBarrier { unsigned* bar; unsigned x; volatile LAS unsigned* st; };
__device__ __forceinline__ XcdBarrier xcd_barrier_post(unsigned* bar, volatile LAS unsigned* st) {
    XcdBarrier b; b.bar = bar; b.x = xb_xcc_id(); b.st = st;
    if (threadIdx.x == 0) (void)xb_add(&bar[XB_XCNT(b.x)], 1u);
    return b;
}
__device__ __forceinline__ void xcd_barrier_complete(unsigned* bar, unsigned x, unsigned& nloc, unsigned& nx) {
    const unsigned G = gridDim.x * gridDim.y * gridDim.z;
    unsigned sum, cnt, mine, sp = 0u;
    for (;;) {
        sum = 0u; cnt = 0u; mine = 0u;
#pragma unroll
        for (unsigned j = 0; j < 16; ++j) { const unsigned c = xb_ld(&bar[XB_XCNT(j)]); sum += c; cnt += (c > 0u) ? 1u : 0u; mine = (j == x) ? c : mine; }
        if (sum == G) break;
        __builtin_amdgcn_s_sleep(1);
        if ((++sp & 255u) == 0u) { if (xb_ld(&bar[XB_TMO])) break; if (sp > XB_SPIN_CAP) { atomicAdd(&bar[XB_TMO], 1u); break; } }
    }
    nloc = mine > 0u ? mine : 1u; nx = cnt > 0u ? cnt : 1u;
}
__device__ __forceinline__ void xcd_barrier(const XcdBarrier& b) {
    asm volatile("s_waitcnt vmcnt(0)" ::: "memory");
    __syncthreads();
    if (threadIdx.x == 0) {
        unsigned* bar = b.bar;
        __builtin_amdgcn_s_waitcnt(0);
        unsigned nloc = b.st[0], nx = b.st[1];
        if (nloc == 0u) { xcd_barrier_complete(bar, b.x, nloc, nx); b.st[0] = nloc; b.st[1] = nx; }
        const unsigned old = xb_add(&bar[XB_XSUB(b.x)], 1u);
        const unsigned gen = old / nloc;
        if (old + 1u == (gen + 1u) * nloc) {
            __builtin_amdgcn_fence(__ATOMIC_RELEASE, "agent");
            asm volatile("s_waitcnt vmcnt(0)" ::: "memory");
            const unsigned og = xb_add(&bar[XB_TOP], 1u);
            const unsigned tg = og / nx;
            if (og + 1u == (tg + 1u) * nx) xb_add(&bar[XB_TOPGEN], 1u);
            else XB_SPIN(xb_ld(&bar[XB_TOPGEN]) == tg, bar);
            __builtin_amdgcn_fence(__ATOMIC_ACQUIRE, "agent");
            xb_add(&bar[XB_XGEN(b.x)], 1u);
            asm volatile("s_waitcnt vmcnt(0)" ::: "memory");
        } else {
            XB_SPIN(xb_ld(&bar[XB_XGEN(b.x)]) == gen, bar);
            __builtin_amdgcn_fence(__ATOMIC_ACQUIRE, "agent");
            asm volatile("s_waitcnt vmcnt(0)" ::: "memory");
        }
    }
    __syncthreads();
}

__device__ __forceinline__ void dep_post(unsigned* cnt) {
    asm volatile("s_waitcnt vmcnt(0)" ::: "memory");
    __syncthreads();
    if (threadIdx.x == 0) { __builtin_amdgcn_fence(__ATOMIC_RELEASE, "agent"); asm volatile("s_waitcnt vmcnt(0)" ::: "memory"); (void)xb_add(cnt, 1u); }
}
__device__ __forceinline__ void dep_wait(unsigned* cnt, unsigned target, unsigned* bar) {
    if (threadIdx.x == 0) { XB_SPIN(xb_ld(cnt) < target, bar); __builtin_amdgcn_fence(__ATOMIC_ACQUIRE, "agent"); asm volatile("s_waitcnt vmcnt(0)" ::: "memory"); }
    __syncthreads();
}

struct Args {
    const float* in[15]; float* out; unsigned char* ws; int ph_lo, ph_hi;
};
struct Frame {
    LAS unsigned char* lds; unsigned* ctl; unsigned char* ws;
    int tid, lane, wave, vcu, G;
};

template <bool F8>
__device__ __forceinline__ void p0_transpose_item(const float* W, int ldw, int srccol0, const float* ks, float cs, void* WTv, int K, int dstrow0, int k0, LAS float* scr, int lane) {
    float t[32];
#pragma unroll
    for (int i = 0; i < 32; ++i) { const int kk = 2 * i + (lane >> 5); t[i] = W[(size_t)(k0 + kk) * ldw + srccol0 + (lane & 31)]; }
    if (ks) {
        float kv[32];
#pragma unroll
        for (int i = 0; i < 32; ++i) kv[i] = ks[k0 + 2 * i + (lane >> 5)];
        asm volatile("" ::: "memory");
#pragma unroll
        for (int i = 0; i < 32; ++i) t[i] *= kv[i];
    }
    asm volatile("" ::: "memory");
#pragma unroll
    for (int i = 0; i < 32; ++i) { const int kk = 2 * i + (lane >> 5); scr[kk * 33 + (lane & 31)] = t[i] * cs; }
    LDS_WAIT(); asm volatile("" ::: "memory");
    const int c = lane & 7;
#pragma unroll
    for (int j = 0; j < 4; ++j) { const int n = (lane >> 3) + 8 * j; const LAS float* sp = scr + (8 * c) * 33 + n;
        if constexpr (F8) {
            u32x2 o;
            o.x = (unsigned)__builtin_amdgcn_cvt_pk_fp8_f32(sp[0 * 33], sp[1 * 33], 0, false); o.x = (unsigned)__builtin_amdgcn_cvt_pk_fp8_f32(sp[2 * 33], sp[3 * 33], (int)o.x, true);
            o.y = (unsigned)__builtin_amdgcn_cvt_pk_fp8_f32(sp[4 * 33], sp[5 * 33], 0, false); o.y = (unsigned)__builtin_amdgcn_cvt_pk_fp8_f32(sp[6 * 33], sp[7 * 33], (int)o.y, true);
            *(u32x2*)((unsigned char*)WTv + (size_t)(dstrow0 + n) * K + k0 + 8 * c) = o;
        } else {
            u32x4 o; o.x = cvtpk(sp[0 * 33], sp[1 * 33]); o.y = cvtpk(sp[2 * 33], sp[3 * 33]); o.z = cvtpk(sp[4 * 33], sp[5 * 33]); o.w = cvtpk(sp[6 * 33], sp[7 * 33]);
            *(u32x4*)((bf16_t*)WTv + (size_t)(dstrow0 + n) * K + k0 + 8 * c) = o;
        } }
    LDS_WAIT(); asm volatile("" ::: "memory");
}

__device__ __forceinline__ void p0_prep(Frame& F, const Args& a) {
    const float* x = a.in[0]; const float* norm_mix = a.in[1]; const float* w_in = a.in[2]; const float* b_in = a.in[3]; const float* w_out = a.in[5];
    const float* norm_ffn = a.in[6]; const float* w_group = a.in[7]; const float* b_group = a.in[8]; const float* w_expert = a.in[9]; const float* b_expert = a.in[10];
    const float* w_gate = a.in[11]; const float* w_up = a.in[12]; const float* w_down = a.in[13];
    bf16_t* WinT = (bf16_t*)(F.ws + WS_WIN); bf16_t* WoutT = (bf16_t*)(F.ws + WS_WOUT); bf16_t* WrT = (bf16_t*)(F.ws + WS_WR);
    float* binp = (float*)(F.ws + WS_WR + 128 * 1024); float* brt = (float*)(F.ws + WS_WR + 160 * 1024);
    bf16_t* W1T = (bf16_t*)(F.ws + WS_W1); bf16_t* W2T = (bf16_t*)(F.ws + WS_W2);
    bf16_t* xb = (bf16_t*)(F.ws + WS_R2); float* rs1 = (float*)(F.ws + WS_RS1); float* gbuf = (float*)(F.ws + WS_GATES);
    LAS float* scr = (LAS float*)(F.lds + F.wave * 8448);
    LAS float* wgs = (LAS float*)(F.lds + 67584);
    const int gw = F.vcu * 8 + F.wave, NGW = F.G * 8, gt = F.vcu * 512 + F.tid, NGT = F.G * 512;
    const float QS = 0.08838834764831845f;
    for (int idx = F.tid; idx < 8192; idx += 512) { const int k = idx >> 3, g = idx & 7; wgs[g * 1024 + k] = w_in[(size_t)k * NPROJ_IN + 2048 + g] * norm_mix[k]; }
    for (int i = gt; i < NPROJ; i += NGT) { const int col = i < 2048 ? i : i + 8; binp[i] = b_in[col] * (i < 512 ? QS : 1.0f); }
    for (int i = gt; i < 48; i += NGT) brt[i] = i < 4 ? b_group[i] : (i < 36 ? b_expert[i - 4] : 0.f);
    for (int i = gt; i < 48 * 1024; i += NGT) { const int j = i >> 10, k = i & 1023; float v = 0.f; if (j < 4) v = w_group[k * 4 + j]; else if (j < 36) v = w_expert[k * 32 + (j - 4)];
        WrT[i] = (bf16_t)(cvtpk(v * norm_ffn[k], 0.f) & 0xffffu); }
    constexpr int I_IN = 16 * 112, I_OUT = 16 * 32, NITEMS = I_IN + I_OUT;
    for (int it = gw; it < NITEMS; it += NGW) {
        int r = it;
        if (r < I_IN) { const int kb = r / 112, nb = r % 112, n0 = 32 * nb; p0_transpose_item<false>(w_in, NPROJ_IN, n0 < 2048 ? n0 : n0 + 8, norm_mix, n0 < 512 ? QS : 1.0f, WinT, 1024, n0, 64 * kb, scr, F.lane); continue; }
        r -= I_IN;
        { const int kb = r / 32, nb = r % 32; p0_transpose_item<false>(w_out, 1024, 32 * nb, nullptr, 1.0f, WoutT, 1024, 32 * nb, 64 * kb, scr, F.lane); }
    }
    __syncthreads();
    const int lane = F.lane;
    constexpr int RW = 2;
    f32x4 vn[RW][4];
#pragma unroll
    for (int rr = 0; rr < RW; ++rr)
#pragma unroll
        for (int j = 0; j < 4; ++j) vn[rr][j] = ((const f32x4*)(x + (size_t)(gw * RW + rr) * D))[64 * j + lane];
    for (int m0 = gw * RW; m0 < NTOK; m0 += NGW * RW) {
        f32x4 v[RW][4];
#pragma unroll
        for (int rr = 0; rr < RW; ++rr)
#pragma unroll
            for (int j = 0; j < 4; ++j) v[rr][j] = vn[rr][j];
        { const int mn = (m0 + NGW * RW < NTOK) ? m0 + NGW * RW : m0;
#pragma unroll
            for (int rr = 0; rr < RW; ++rr)
#pragma unroll
                for (int j = 0; j < 4; ++j) vn[rr][j] = ((const f32x4*)(x + (size_t)(mn + rr) * D))[64 * j + lane]; }
        float ss[RW], gd[RW][8];
#pragma unroll
        for (int rr = 0; rr < RW; ++rr) { ss[rr] = 0.f;
#pragma unroll
            for (int j = 0; j < 4; ++j) ss[rr] += (v[rr][j].x * v[rr][j].x + v[rr][j].y * v[rr][j].y) + (v[rr][j].z * v[rr][j].z + v[rr][j].w * v[rr][j].w);
#pragma unroll
            for (int g = 0; g < 8; ++g) gd[rr][g] = 0.f; }
#pragma unroll
        for (int g = 0; g < 8; ++g)
#pragma unroll
            for (int j = 0; j < 4; ++j) { const f32x4 w = *(const LAS f32x4*)(wgs + g * 1024 + 256 * j + 4 * lane);
#pragma unroll
                for (int rr = 0; rr < RW; ++rr) gd[rr][g] += (v[rr][j].x * w.x + v[rr][j].y * w.y) + (v[rr][j].z * w.z + v[rr][j].w * w.w); }
#pragma unroll
        for (int rr = 0; rr < RW; ++rr) {
            u32x2* o8 = (u32x2*)(xb + (size_t)(m0 + rr) * D) + lane;
#pragma unroll
            for (int j = 0; j < 4; ++j) { u32x2 w; w.x = cvtpk(v[rr][j].x, v[rr][j].y); w.y = cvtpk(v[rr][j].z, v[rr][j].w); o8[64 * j] = w; }
            const float st = wave_sum(ss[rr]);
            const float rs = 1.0f / sqrtf(st * (1.0f / D) + RMS_EPS);
            float a4[4], a2[2], a1;
            const bool h5 = (lane & 32) != 0, h4 = (lane & 16) != 0, h3 = (lane & 8) != 0;
#pragma unroll
            for (int i = 0; i < 4; ++i) { const float keep = h5 ? gd[rr][4 + i] : gd[rr][i], send = h5 ? gd[rr][i] : gd[rr][4 + i]; a4[i] = keep + __shfl_xor(send, 32); }
#pragma unroll
            for (int i = 0; i < 2; ++i) { const float keep = h4 ? a4[2 + i] : a4[i], send = h4 ? a4[i] : a4[2 + i]; a2[i] = keep + __shfl_xor(send, 16); }
            { const float keep = h3 ? a2[1] : a2[0], send = h3 ? a2[0] : a2[1]; a1 = keep + __shfl_xor(send, 8); }
            a1 += __shfl_xor(a1, 4); a1 += __shfl_xor(a1, 2); a1 += __shfl_xor(a1, 1);
            if ((lane & 7) == 0) gbuf[(size_t)(m0 + rr) * 8 + (lane >> 3)] = rs * a1 + b_in[2048 + (lane >> 3)];
            if (lane == 0) rs1[m0 + rr] = rs;
        }
    }
}
constexpr int NITEMS_GU = NE * 512, NITEMS_DN = NE * 256;
__device__ __forceinline__ void expert_item(Frame& F, const Args& a, bool down, int it) {
    const float* norm_ffn = a.in[6]; const float* w_gate = a.in[11]; const float* w_up = a.in[12]; const float* w_down = a.in[13];
    unsigned char* W1T = (unsigned char*)(F.ws + WS_W1); unsigned char* W2T = (unsigned char*)(F.ws + WS_W2);
    LAS float* scr = (LAS float*)(F.lds + F.wave * 8448);
    const float ws = (float)(1 << FP8_W_SHIFT);
    if (!down) { const int e = it >> 9, r = it & 511, up = r >> 8, rr = r & 255, kb = rr / 16, nb = rr % 16, f0 = 32 * nb;
        p0_transpose_item<true>((up ? w_up : w_gate) + (size_t)e * 1024 * 512, 512, f0, norm_ffn, ws, W1T + (size_t)e * 1024 * 1024, 1024, 256 * (f0 >> 7) + (f0 & 127) + 128 * up, 64 * kb, scr, F.lane); }
    else { const int e = it >> 8, rr = it & 255, kb = rr / 32, nb = rr % 32; p0_transpose_item<true>(w_down + (size_t)e * 512 * 1024, 1024, 32 * nb, nullptr, ws, W2T + (size_t)e * 1024 * 512, 512, 32 * nb, 64 * kb, scr, F.lane); }
}
constexpr int QB = 16;
__device__ __forceinline__ void expert_queue(Frame& F, const Args& a, bool down) {
    volatile LAS unsigned* qw = (volatile LAS unsigned*)(F.lds + LDSCTL_OFF + 64);
    const int nitems = down ? NITEMS_DN : NITEMS_GU;
    for (;;) {
        __syncthreads();
        if (F.tid == 0) qw[0] = __hip_atomic_fetch_add(F.ctl + (down ? CW_QUEUE2 : CW_QUEUE), (unsigned)QB, __ATOMIC_RELAXED, __HIP_MEMORY_SCOPE_AGENT);
        __syncthreads();
        const int base = (int)qw[0];
        if (base >= nitems) break;
        for (int i = 0; i < QB / 8; ++i) { const int it = base + F.wave * (QB / 8) + i; if (it < nitems) expert_item(F, a, down, it); }
    }
}

constexpr int M2_KS = 0, M2_QS = 34816, M2_WVS = 69632, M2_PS = 91136, M2_CS = 109568, M2_MCH = 135680, M2_END = 136704;
constexpr int M2_KSZ = 17408, M2_WSZ = 7168, M2_PSZ = 9216, M2_CSZ = 13056;
constexpr int ML_QSTR = 272, ML_WSTR = 112, ML_PSTR = 144;
__device__ __forceinline__ bf16x8 tr_frag(const LAS unsigned char* base, int stride) {
    const s16x4 lo = __builtin_amdgcn_ds_read_tr16_b64_v4i16((LAS s16x4*)(base));
    const s16x4 hi = __builtin_amdgcn_ds_read_tr16_b64_v4i16((LAS s16x4*)(base + 4 * stride));
    return (bf16x8){lo[0], lo[1], lo[2], lo[3], hi[0], hi[1], hi[2], hi[3]};
}
__device__ __forceinline__ u32x4 scale_bf8(u32x4 v, float w) {
    u32x4 o; o.x = cvtpk(bflo(v.x) * w, bfhi(v.x) * w); o.y = cvtpk(bflo(v.y) * w, bfhi(v.y) * w); o.z = cvtpk(bflo(v.z) * w, bfhi(v.z) * w); o.w = cvtpk(bflo(v.w) * w, bfhi(v.w) * w); return o;
}
struct MlCtx {
    LAS unsigned char* L; const LAS float* mch; const float* gsc;
    const bf16_t* projb; bf16_t* ymcb; unsigned ok, ov, oq, oo, oy;
    int tid, lane, wid, r, q, qrow0, qseg, vrow, vseg, srow, lt, et, dt, lrow, trrow, trcol;
};
struct MlRegs {
    u32x4 sk0[2], sk1[2], sq0[2], sq1[2], sv[2]; float ss[2];
    float pm[3], bc[3]; u32x2 og[2];
    f32x4 accC[3], xe, xd;
};
constexpr size_t ML_CSTEP = (size_t)CH * NPROJ;
template <bool ST, bool FG, bool OUT, int K3, int K2>
__device__ __forceinline__ void ml_iter(const MlCtx& C, MlRegs& R, const int k) {
    LAS unsigned char* L = C.L; const int r = C.r, q = C.q, lt = C.lt, et = C.et, dt = C.dt, lrow = C.lrow, trrow = C.trrow, trcol = C.trcol;
    constexpr int S1 = (K3 + 1) % 3, S2 = (K3 + 2) % 3;
    const u32x4 rk0 = R.sk0[K2], rk1 = R.sk1[K2], rq0 = R.sq0[K2], rq1 = R.sq1[K2], rv = R.sv[K2]; const float sst = R.ss[K2];
    const float pm_o = R.pm[S1], bc_o = R.bc[S1]; const u32x2 og_o = R.og[K2];
    const float pm_f = R.pm[S2];
    const f32x4 xe_o = R.xe, xd_o = R.xd;
    {
        const int k2 = (k + 2 < NCH) ? k + 2 : NCH - 1, k1 = (k + 1 < NCH) ? k + 1 : NCH - 1, k0 = (k < NCH) ? k : NCH - 1;
        const size_t a2 = (size_t)k2 * ML_CSTEP, a1 = (size_t)k1 * ML_CSTEP;
        const bf16_t* b2 = C.projb + a2; const bf16_t* b1 = C.projb + a1;
        R.sk0[K2] = *(const u32x4*)(b2 + C.ok); R.sk1[K2] = *(const u32x4*)(b2 + 32 * NPROJ + C.ok); R.sq0[K2] = *(const u32x4*)(b2 + C.ok - 512); R.sq1[K2] = *(const u32x4*)(b2 + 32 * NPROJ + C.ok - 512); R.sv[K2] = *(const u32x4*)(b2 + C.ov); R.ss[K2] = C.gsc[k2 * 192 + C.srow];
        R.pm[S1] = C.gsc[k1 * 192 + 64 + lrow]; R.bc[S1] = C.gsc[k1 * 192 + 128 + lrow];
        { const int km = (k >= 1) ? ((k - 1 < NCH) ? k - 1 : NCH - 1) : 0; R.og[K2 ^ 1] = *(const u32x2*)(C.projb + (size_t)km * ML_CSTEP + C.oo); }
    }
    if constexpr (ST) {
        const float M63s = C.mch[2 * k + 1]; const float w = __expf(sst - M63s);
        LAS unsigned char* ks = L + M2_KS + K2 * M2_KSZ; LAS unsigned char* wv = L + M2_WVS + K3 * M2_WSZ;
        *(LAS u32x4*)(ks + C.qrow0 * ML_QSTR + C.qseg * 16) = rk0; *(LAS u32x4*)(ks + (C.qrow0 + 32) * ML_QSTR + C.qseg * 16) = rk1;
        { LAS unsigned char* qs = L + M2_QS + K2 * M2_KSZ; *(LAS u32x4*)(qs + C.qrow0 * ML_QSTR + C.qseg * 16) = rq0; *(LAS u32x4*)(qs + (C.qrow0 + 32) * ML_QSTR + C.qseg * 16) = rq1; }
        if (C.tid < 256) *(LAS u32x4*)(wv + C.vrow * ML_WSTR + C.vseg * 16) = scale_bf8(rv, w);
        if (C.wid == 4) *(LAS u32x4*)(wv + C.lane * ML_WSTR + 64) = (u32x4){cvtpk(w, 0.f), 0u, 0u, 0u};
    }
    f32x4 ie = (f32x4){0.f, 0.f, 0.f, 0.f}, id = ie;
    if constexpr (OUT) {
        const LAS unsigned char* ps = L + M2_PS + K2 * M2_PSZ; const LAS unsigned char* wv = L + M2_WVS + S1 * M2_WSZ;
        bf16x8 bp[2], av[2], ad[2];
#pragma unroll
        for (int js = 0; js < 2; ++js) {
            bp[js] = *(const LAS bf16x8*)(ps + lrow * ML_PSTR + js * 64 + q * 16);
            av[js] = tr_frag(wv + (32 * js + 8 * q + trrow) * ML_WSTR + (16 * et + trcol) * 2, ML_WSTR);
            ad[js] = tr_frag(wv + (32 * js + 8 * q + trrow) * ML_WSTR + (32 + trcol) * 2, ML_WSTR);
        }
#pragma unroll
        for (int js = 0; js < 2; ++js) { ie = __builtin_amdgcn_mfma_f32_16x16x32_bf16(av[js], bp[js], ie, 0, 0, 0); id = __builtin_amdgcn_mfma_f32_16x16x32_bf16(ad[js], bp[js], id, 0, 0, 0); }
    }
    if constexpr (FG) {
        const int j = k - 1;
        const LAS unsigned char* ksF = L + M2_KS + (K2 ^ 1) * M2_KSZ; const LAS unsigned char* wvF = L + M2_WVS + S2 * M2_WSZ; const LAS unsigned char* cs = L + M2_CS + (K2 ^ 1) * M2_CSZ;
        LAS unsigned char* ps = L + M2_PS + (K2 ^ 1) * M2_PSZ; LAS unsigned char* csn = L + M2_CS + K2 * M2_CSZ;
        const float mp = C.mch[2 * j], M63 = C.mch[2 * j + 1];
        const float fl = __expf(M63 - fmaxf(mp, pm_f)), decay = __expf(mp - M63);
        f32x4 sacc[2], xe = (f32x4){0.f, 0.f, 0.f, 0.f}, xd = xe;
        bf16x8 qf[4];
        { const LAS unsigned char* qs = L + M2_QS + (K2 ^ 1) * M2_KSZ;
#pragma unroll
          for (int ds = 0; ds < 4; ++ds) qf[ds] = *(const LAS bf16x8*)(qs + lrow * ML_QSTR + ds * 64 + q * 16); }
#pragma unroll
        for (int ti = 0; ti < 2; ++ti) {
            const int jt = et + 2 * ti, jtc = jt <= lt ? jt : lt;
            bf16x8 kf[4], ax[4];
#pragma unroll
            for (int ds = 0; ds < 4; ++ds) { kf[ds] = *(const LAS bf16x8*)(ksF + (16 * jtc + r) * ML_QSTR + ds * 64 + q * 16);
                ax[ds] = *(const LAS bf16x8*)(cs + ((ti ? 32 : 16 * et) + r) * ML_QSTR + ds * 64 + q * 16); }
            sacc[ti] = (f32x4){0.f, 0.f, 0.f, 0.f};
#pragma unroll
            for (int ds = 0; ds < 4; ++ds) { const bf16x8 bq = qf[ds];
                sacc[ti] = __builtin_amdgcn_mfma_f32_16x16x32_bf16(kf[ds], bq, sacc[ti], 0, 0, 0);
                if (ti == 0) xe = __builtin_amdgcn_mfma_f32_16x16x32_bf16(ax[ds], bq, xe, 0, 0, 0); else xd = __builtin_amdgcn_mfma_f32_16x16x32_bf16(ax[ds], bq, xd, 0, 0, 0); }
            __builtin_amdgcn_sched_barrier(0);
        }
        R.xe = xe; R.xd = xd;
        {
            bf16x8 ga[2], gb[2][3];
#pragma unroll
            for (int js = 0; js < 2; ++js) { const int jrow = 32 * js + 8 * q + trrow;
                ga[js] = tr_frag(ksF + jrow * ML_QSTR + (16 * dt + trcol) * 2, ML_QSTR);
#pragma unroll
                for (int e3 = 0; e3 < 3; ++e3) gb[js][e3] = tr_frag(wvF + jrow * ML_WSTR + (16 * e3 + trcol) * 2, ML_WSTR); }
#pragma unroll
            for (int i = 0; i < 3; ++i) R.accC[i] = R.accC[i] * decay;
#pragma unroll
            for (int js = 0; js < 2; ++js)
#pragma unroll
                for (int e3 = 0; e3 < 3; ++e3) R.accC[e3] = __builtin_amdgcn_mfma_f32_16x16x32_bf16(ga[js], gb[js][e3], R.accC[e3], 0, 0, 0);
        }
#pragma unroll
        for (int ti = 0; ti < 2; ++ti) {
            const int jt = et + 2 * ti;
            if (jt <= lt) { const int j0 = 16 * jt + 4 * q; float p[4];
#pragma unroll
                for (int i = 0; i < 4; ++i) p[i] = (j0 + i <= lrow) ? sacc[ti][i] * fl : 0.f;
                *(LAS u32x2*)(ps + lrow * ML_PSTR + j0 * 2) = (u32x2){cvtpk(p[0], p[1]), cvtpk(p[2], p[3])}; }
        }
#pragma unroll
        for (int e3 = 0; e3 < 3; ++e3) *(LAS u32x2*)(csn + (16 * e3 + r) * ML_QSTR + (16 * dt + 4 * q) * 2) = (u32x2){cvtpk(R.accC[e3][0], R.accC[e3][1]), cvtpk(R.accC[e3][2], R.accC[e3][3])};
    }
    if constexpr (OUT) {
        const int j = k - 2;
        const float mp = C.mch[2 * j]; const float Ml = fmaxf(mp, pm_o); const float wl = __expf(mp - Ml), el = __expf(-bc_o - Ml);
        float den = id[0] + wl * xd_o[0]; den = __shfl(den, r);
        const float nrm = __builtin_amdgcn_rcpf(fmaxf(fabsf(den), el));
        const float o0 = bflo(og_o.x), o1 = bfhi(og_o.x), o2 = bflo(og_o.y), o3 = bfhi(og_o.y);
        const float y0 = (ie[0] + wl * xe_o[0]) * nrm * __builtin_amdgcn_rcpf(1.0f + __expf(-o0)), y1 = (ie[1] + wl * xe_o[1]) * nrm * __builtin_amdgcn_rcpf(1.0f + __expf(-o1));
        const float y2 = (ie[2] + wl * xe_o[2]) * nrm * __builtin_amdgcn_rcpf(1.0f + __expf(-o2)), y3 = (ie[3] + wl * xe_o[3]) * nrm * __builtin_amdgcn_rcpf(1.0f + __expf(-o3));
        *(u32x2*)(C.ymcb + (size_t)j * CH * D + C.oy) = (u32x2){cvtpk(y0, y1), cvtpk(y2, y3)};
    }
    __syncthreads();
}
__device__ __forceinline__ void mlstm_unit(Frame& F, int unit) {
    const bf16_t* proj = (const bf16_t*)(F.ws + WS_R1); const float* gbuf = (const float*)(F.ws + WS_GATES); bf16_t* ymc = (bf16_t*)(F.ws + WS_YMC);
    float* gsc = (float*)(F.ws + WS_GSC) + (size_t)unit * (NCH * 192);
    LAS unsigned char* L = F.lds;
    const int b = unit >> 4, h = (unit >> 2) & 3, es = unit & 3;
    const int tid = F.tid, lane = F.lane, wid = F.wave, r = lane & 15, q = lane >> 4;
    const size_t tok0 = (size_t)b * SEQ;
    LAS float* mch = (LAS float*)(L + M2_MCH);
    LAS float* gtv = mch + 128;
    for (int i = tid; i < M2_MCH / 16; i += 512) *(LAS u32x4*)(L + i * 16) = (u32x4){0u, 0u, 0u, 0u};
    {
        float bcv[8], sjv[8], pmv[8];
#pragma unroll
        for (int i = 0; i < 8; ++i) { const float* pg = gbuf + (tok0 + (size_t)(wid + 8 * i) * CH + lane) * 8 + h; const float ig = pg[0], fg = pg[4];
            bcv[i] = fminf(fg, 0.f) - log1pf(__expf(-fabsf(fg))); sjv[i] = ig; }
#pragma unroll
        for (int o = 1; o < 64; o <<= 1) {
#pragma unroll
            for (int i = 0; i < 8; ++i) { const float t = __shfl_up(bcv[i], o); bcv[i] = (lane >= o) ? bcv[i] + t : bcv[i]; } }
#pragma unroll
        for (int i = 0; i < 8; ++i) { sjv[i] = sjv[i] - bcv[i]; pmv[i] = sjv[i]; }
#pragma unroll
        for (int o = 1; o < 64; o <<= 1) {
#pragma unroll
            for (int i = 0; i < 8; ++i) { const float t = __shfl_up(pmv[i], o); pmv[i] = (lane >= o) ? fmaxf(pmv[i], t) : pmv[i]; } }
#pragma unroll
        for (int i = 0; i < 8; ++i) { const int c = wid + 8 * i;
            gsc[c * 192 + lane] = sjv[i]; gsc[c * 192 + 64 + lane] = pmv[i]; gsc[c * 192 + 128 + lane] = bcv[i];
            if (lane == 63) { gtv[c] = bcv[i]; gtv[64 + c] = pmv[i]; } }
    }
    __syncthreads();
    if (tid == 0) { float m = 0.f; for (int c = 0; c < NCH; ++c) { const float M63 = fmaxf(m, gtv[64 + c]); mch[2 * c] = m; mch[2 * c + 1] = M63; m = gtv[c] + M63; } }
    MlCtx C; MlRegs R;
    C.L = L; C.mch = mch; C.gsc = gsc; C.tid = tid; C.lane = lane; C.wid = wid; C.r = r; C.q = q;
    C.qrow0 = tid >> 4; C.qseg = tid & 15; C.vrow = (tid & 255) >> 2; C.vseg = tid & 3; C.srow = (wid == 4) ? lane : C.vrow;
    C.lt = wid & 3; C.et = wid >> 2; C.dt = wid; C.lrow = 16 * C.lt + r; C.trrow = (lane & 15) >> 2; C.trcol = (lane & 3) * 4;
    C.projb = proj + tok0 * NPROJ; C.ymcb = ymc + tok0 * D;
    C.ok = (unsigned)(C.qrow0 * NPROJ + 512 + h * DH + C.qseg * 8);
    C.ov = (unsigned)(C.vrow * NPROJ + 1024 + h * DH + es * 32 + C.vseg * 8);
    C.oo = (unsigned)(C.lrow * NPROJ + 1536 + h * DH + es * 32 + 16 * C.et + 4 * q);
    C.oy = (unsigned)(C.lrow * D + h * DH + es * 32 + 16 * C.et + 4 * q);
    R.sk0[0] = *(const u32x4*)(C.projb + C.ok); R.sk1[0] = *(const u32x4*)(C.projb + 32 * NPROJ + C.ok); R.sq0[0] = *(const u32x4*)(C.projb + C.ok - 512); R.sq1[0] = *(const u32x4*)(C.projb + 32 * NPROJ + C.ok - 512); R.sv[0] = *(const u32x4*)(C.projb + C.ov);
    R.sk0[1] = *(const u32x4*)(C.projb + ML_CSTEP + C.ok); R.sk1[1] = *(const u32x4*)(C.projb + ML_CSTEP + 32 * NPROJ + C.ok); R.sq0[1] = *(const u32x4*)(C.projb + ML_CSTEP + C.ok - 512); R.sq1[1] = *(const u32x4*)(C.projb + ML_CSTEP + 32 * NPROJ + C.ok - 512); R.sv[1] = *(const u32x4*)(C.projb + ML_CSTEP + C.ov);
#pragma unroll
    for (int sl = 0; sl < 3; ++sl) { R.pm[sl] = 0.f; R.bc[sl] = 0.f; }
    R.og[0] = (u32x2){0u, 0u}; R.og[1] = R.og[0];
#pragma unroll
    for (int i = 0; i < 3; ++i) R.accC[i] = (f32x4){0.f, 0.f, 0.f, 0.f};
    R.xe = (f32x4){0.f, 0.f, 0.f, 0.f}; R.xd = R.xe;
    __syncthreads();
    R.ss[0] = gsc[C.srow]; R.ss[1] = gsc[192 + C.srow]; R.pm[0] = gsc[64 + C.lrow]; R.bc[0] = gsc[128 + C.lrow];
    ml_iter<true, false, false, 0, 0>(C, R, 0);
    ml_iter<true, true, false, 1, 1>(C, R, 1);
    ml_iter<true, true, true, 2, 0>(C, R, 2);
    ml_iter<true, true, true, 0, 1>(C, R, 3);
    for (int k = 4; k < NCH; k += 6) {
        ml_iter<true, true, true, 1, 0>(C, R, k);     ml_iter<true, true, true, 2, 1>(C, R, k + 1); ml_iter<true, true, true, 0, 0>(C, R, k + 2);
        ml_iter<true, true, true, 1, 1>(C, R, k + 3); ml_iter<true, true, true, 2, 0>(C, R, k + 4); ml_iter<true, true, true, 0, 1>(C, R, k + 5);
    }
    ml_iter<false, true, true, 1, 0>(C, R, NCH);
    ml_iter<false, false, true, 2, 1>(C, R, NCH + 1);
}
__device__ __forceinline__ void conv_part(Frame& F, const float* conv_w, int part) {
    const bf16_t* proj = (const bf16_t*)(F.ws + WS_R1); bf16_t* ymc = (bf16_t*)(F.ws + WS_YMC);
    const int cg = F.tid & 63, sub = F.tid >> 6; const int T0 = part * 256 + sub * 32;
    float w0[8], w1[8], w2[8], u1[8], u2[8];
#pragma unroll
    for (int i = 0; i < 8; ++i) { w0[i] = conv_w[8 * cg + i]; w1[i] = conv_w[512 + 8 * cg + i]; w2[i] = conv_w[1024 + 8 * cg + i]; u1[i] = 0.f; u2[i] = 0.f; }
    if ((T0 & (SEQ - 1)) != 0) {
        const bf16_t* p1 = proj + (size_t)(T0 - 1) * NPROJ + 2560 + 8 * cg; const bf16_t* p2 = proj + (size_t)(T0 - 2) * NPROJ + 2560 + 8 * cg;
        const u32x4 c1 = *(const u32x4*)p1, x1 = *(const u32x4*)(p1 + 512), c2 = *(const u32x4*)p2, x2 = *(const u32x4*)(p2 + 512);
#pragma unroll
        for (int i = 0; i < 4; ++i) { u1[2 * i] = bflo(c1[i]) * bflo(x1[i]); u1[2 * i + 1] = bfhi(c1[i]) * bfhi(x1[i]); u2[2 * i] = bflo(c2[i]) * bflo(x2[i]); u2[2 * i + 1] = bfhi(c2[i]) * bfhi(x2[i]); }
    }
#pragma unroll 4
    for (int t = 0; t < 32; ++t) {
        const bf16_t* pp = proj + (size_t)(T0 + t) * NPROJ + 2048 + 8 * cg;
        const u32x4 cb = *(const u32x4*)pp, cc = *(const u32x4*)(pp + 512), cx = *(const u32x4*)(pp + 1024);
        float y[8];
#pragma unroll
        for (int i = 0; i < 4; ++i) {
            const float ua = bflo(cc[i]) * bflo(cx[i]), ub = bfhi(cc[i]) * bfhi(cx[i]);
            y[2 * i] = bflo(cb[i]) * (w0[2 * i] * u2[2 * i] + w1[2 * i] * u1[2 * i] + w2[2 * i] * ua);
            y[2 * i + 1] = bfhi(cb[i]) * (w0[2 * i + 1] * u2[2 * i + 1] + w1[2 * i + 1] * u1[2 * i + 1] + w2[2 * i + 1] * ub);
            u2[2 * i] = u1[2 * i]; u2[2 * i + 1] = u1[2 * i + 1]; u1[2 * i] = ua; u1[2 * i + 1] = ub;
        }
        *(u32x4*)(ymc + (size_t)(T0 + t) * D + 512 + 8 * cg) = (u32x4){cvtpk(y[0], y[1]), cvtpk(y[2], y[3]), cvtpk(y[4], y[5]), cvtpk(y[6], y[7])};
    }
}

constexpr int RT_WSTR = 2064, RT_SCR = 99328, RT_LCNT = 124928, RT_GBASE = 125184, RT_BIAS = 125440;
__device__ __forceinline__ void p4_router(Frame& F) {
    const bf16_t* WrT = (const bf16_t*)(F.ws + WS_WR); const float* brt = (const float*)(F.ws + WS_WR + 160 * 1024);
    const bf16_t* x1b = (const bf16_t*)(F.ws + WS_X1B); unsigned char* x1q = (unsigned char*)(F.ws + WS_X1Q); int* list = (int*)(F.ws + WS_LIST); float* lrs = (float*)(F.ws + WS_LRS); unsigned* tokinfo = (unsigned*)(F.ws + WS_TOKINFO);
    unsigned* gcnt = F.ctl + CW_CNT;
    LAS unsigned char* L = F.lds; const int tid = F.tid, lane = F.lane, wid = F.wave, r = lane & 15, q = lane >> 4;
    LAS int* lcnt = (LAS int*)(L + RT_LCNT); LAS int* gbase = (LAS int*)(L + RT_GBASE); LAS float* lbias = (LAS float*)(L + RT_BIAS);
    LAS float* scr = (LAS float*)(L + RT_SCR + wid * 3072);
    for (int p = tid; p < 6144; p += 512) { const int row = p >> 7, seg = p & 127; *(LAS u32x4*)(L + row * RT_WSTR + seg * 16) = *(const u32x4*)(WrT + (size_t)p * 8); }
    if (tid < 48) lbias[tid] = brt[tid];
    for (int tile = F.vcu; tile < NTOK / 128; tile += F.G) {
        if (tid < 32) lcnt[tid] = 0;
        __syncthreads();
        const int tokb = tile * 128 + wid * 16;
        f32x4 acc[3]; acc[0] = (f32x4){0.f, 0.f, 0.f, 0.f}; acc[1] = acc[0]; acc[2] = acc[0];
        float ss = 0.f;
        const bf16_t* brow = x1b + (size_t)(tokb + r) * D + 8 * q; unsigned char* qrow = x1q + (size_t)(tokb + r) * D + 8 * q;
#pragma unroll 8
        for (int ks = 0; ks < 32; ++ks) {
            const u32x4 pk = *(const u32x4*)(brow + 32 * ks);
            u32x2 q8;
#pragma unroll
            for (int i = 0; i < 4; ++i) { const float lo = bflo(pk[i]), hi = bfhi(pk[i]); ss += lo * lo + hi * hi;
                if (i == 0) q8.x = (unsigned)__builtin_amdgcn_cvt_pk_fp8_f32(lo, hi, 0, false); else if (i == 1) q8.x = (unsigned)__builtin_amdgcn_cvt_pk_fp8_f32(lo, hi, (int)q8.x, true);
                else if (i == 2) q8.y = (unsigned)__builtin_amdgcn_cvt_pk_fp8_f32(lo, hi, 0, false); else q8.y = (unsigned)__builtin_amdgcn_cvt_pk_fp8_f32(lo, hi, (int)q8.y, true); }
            *(u32x2*)(qrow + 32 * ks) = q8;
            const bf16x8 af = __builtin_bit_cast(bf16x8, pk);
#pragma unroll
            for (int nt = 0; nt < 3; ++nt) { const bf16x8 bfr = *(const LAS bf16x8*)(L + (16 * nt + r) * RT_WSTR + ks * 64 + q * 16); acc[nt] = __builtin_amdgcn_mfma_f32_16x16x32_bf16(af, bfr, acc[nt], 0, 0, 0); }
        }
        ss += __shfl_xor(ss, 16); ss += __shfl_xor(ss, 32);
        const float rs = 1.0f / sqrtf(ss * (1.0f / D) + RMS_EPS);
#pragma unroll
        for (int nt = 0; nt < 3; ++nt)
#pragma unroll
            for (int i = 0; i < 4; ++i) scr[(4 * q + i) * 48 + 16 * nt + r] = acc[nt][i];
        LDS_WAIT(); asm volatile("" ::: "memory");
        int e0 = 0, e1 = 0, p0 = 0, p1 = 0; float w0 = 0.f, w1 = 0.f;
        if (lane < 16) {
            const LAS float* lg = scr + lane * 48;
            float gl[4];
#pragma unroll
            for (int i = 0; i < 4; ++i) gl[i] = rs * lg[i] + lbias[i];
            int g = 0; float gm = gl[0];
#pragma unroll
            for (int i = 1; i < 4; ++i) if (gl[i] > gm) { gm = gl[i]; g = i; }
            float gs = 0.f;
#pragma unroll
            for (int i = 0; i < 4; ++i) gs += __expf(gl[i] - gm);
            const float pgrp = 1.0f / gs;
            float v0 = -3.0e38f, v1 = -3.0e38f; int i0 = 0, i1 = 0;
#pragma unroll
            for (int i = 0; i < 8; ++i) { const float v = rs * lg[4 + 8 * g + i] + lbias[4 + 8 * g + i];
                if (v > v0) { v1 = v0; i1 = i0; v0 = v; i0 = i; } else if (v > v1) { v1 = v; i1 = i; } }
            const float ex = __expf(v1 - v0); w0 = pgrp / (1.0f + ex); w1 = pgrp * ex / (1.0f + ex);
            e0 = 8 * g + i0; e1 = 8 * g + i1;
            p0 = __hip_atomic_fetch_add(lcnt + e0, 1, __ATOMIC_RELAXED, __HIP_MEMORY_SCOPE_WORKGROUP); p1 = __hip_atomic_fetch_add(lcnt + e1, 1, __ATOMIC_RELAXED, __HIP_MEMORY_SCOPE_WORKGROUP);
        }
        __syncthreads();
        if (tid < 32) { const int n = lcnt[tid]; gbase[tid] = n ? (int)atomicAdd(gcnt + tid, (unsigned)n) : 0; }
        __syncthreads();
        if (lane < 16) {
            const int tok = tokb + lane; p0 += gbase[e0]; p1 += gbase[e1];
            list[(size_t)e0 * LCAP + p0] = tok; list[(size_t)e1 * LCAP + p1] = tok; lrs[(size_t)e0 * LCAP + p0] = rs; lrs[(size_t)e1 * LCAP + p1] = rs;
            *(u32x4*)(tokinfo + (size_t)tok * 8) = (u32x4){(unsigned)e0, (unsigned)p0, __float_as_uint(w0), (unsigned)e1};
            *(u32x4*)(tokinfo + (size_t)tok * 8 + 4) = (u32x4){(unsigned)p1, __float_as_uint(w1), 0u, 0u};
        }
        __syncthreads();
    }
}
__device__ __forceinline__ void moe_tiles(Frame& F) {
    LAS int* tb = (LAS int*)(F.lds + TB_OFF); LAS int* cn = (LAS int*)(F.lds + CNT_OFF);
    __syncthreads();
    if (F.tid < 32) cn[F.tid] = (int)__hip_atomic_load(F.ctl + CW_CNT + F.tid, __ATOMIC_RELAXED, __HIP_MEMORY_SCOPE_AGENT);
    __syncthreads();
    if (F.tid == 0) { int s = 0; for (int e = 0; e < NE; ++e) { tb[e] = s; s += (cn[e] + 255) >> 8; } tb[NE] = s; }
    __syncthreads();
}
__device__ __forceinline__ void p7_final(Frame& F, float* out, const float* gfin) {
    const unsigned char* y2 = (const unsigned char*)(F.ws + WS_Y2); const bf16_t* x1b = (const bf16_t*)(F.ws + WS_X1B); const unsigned* tokinfo = (const unsigned*)(F.ws + WS_TOKINFO);
    const LAS int* tb = (const LAS int*)(F.lds + TB_OFF);
    const int gw = F.vcu * 8 + F.wave, NGW = F.G * 8;
    f32x4 gf[4];
#pragma unroll
    for (int j = 0; j < 4; ++j) gf[j] = ((const f32x4*)gfin)[64 * j + F.lane];
    const float ys = 1.0f / (float)(1 << FP8_Y_SHIFT);
    for (int m0 = gw * 2; m0 < NTOK; m0 += NGW * 2) {
        u32x2 xv[2][4]; unsigned ya[2][4], yb[2][4]; float w0s[2], w1s[2];
#pragma unroll
        for (int rr = 0; rr < 2; ++rr) { const int m = m0 + rr;
            const u32x4 i0 = *(const u32x4*)(tokinfo + (size_t)m * 8), i1 = *(const u32x4*)(tokinfo + (size_t)m * 8 + 4);
            const int e0 = (int)i0.x, p0 = (int)i0.y, e1 = (int)i0.w, p1 = (int)i1.x; w0s[rr] = __uint_as_float(i0.z) * ys; w1s[rr] = __uint_as_float(i1.y) * ys;
            const size_t r0 = (size_t)tb[e0] * 256 + p0, r1 = (size_t)tb[e1] * 256 + p1;
            const u32x2* xr = (const u32x2*)(x1b + (size_t)m * D) + F.lane; const unsigned* pa = (const unsigned*)(y2 + r0 * D) + F.lane; const unsigned* pb = (const unsigned*)(y2 + r1 * D) + F.lane;
#pragma unroll
            for (int j = 0; j < 4; ++j) { xv[rr][j] = xr[64 * j]; ya[rr][j] = pa[64 * j]; yb[rr][j] = pb[64 * j]; } }
#pragma unroll
        for (int rr = 0; rr < 2; ++rr) {
            f32x4 v[4]; float ss = 0.f;
#pragma unroll
            for (int j = 0; j < 4; ++j) { const unsigned a = ya[rr][j], bq = yb[rr][j];
                const f32x2 a01 = __builtin_amdgcn_cvt_pk_f32_fp8((int)a, false), a23 = __builtin_amdgcn_cvt_pk_f32_fp8((int)a, true);
                const f32x2 b01 = __builtin_amdgcn_cvt_pk_f32_fp8((int)bq, false), b23 = __builtin_amdgcn_cvt_pk_f32_fp8((int)bq, true);
                v[j].x = bflo(xv[rr][j].x) + w0s[rr] * a01.x + w1s[rr] * b01.x; v[j].y = bfhi(xv[rr][j].x) + w0s[rr] * a01.y + w1s[rr] * b01.y;
                v[j].z = bflo(xv[rr][j].y) + w0s[rr] * a23.x + w1s[rr] * b23.x; v[j].w = bfhi(xv[rr][j].y) + w0s[rr] * a23.y + w1s[rr] * b23.y;
                ss += (v[j].x * v[j].x + v[j].y * v[j].y) + (v[j].z * v[j].z + v[j].w * v[j].w); }
            ss = wave_sum(ss);
            const float rs = 1.0f / sqrtf(ss * (1.0f / D) + RMS_EPS);
            f32x4* orow = (f32x4*)(out + (size_t)(m0 + rr) * D) + F.lane;
#pragma unroll
            for (int j = 0; j < 4; ++j) orow[64 * j] = v[j] * rs * gf[j];
        }
    }
}

constexpr int NPHASE = 8;
__global__ void __launch_bounds__(512, 2) hymba_fwd(Args args) {
    extern __shared__ __attribute__((aligned(16))) unsigned char lds_raw[];
    Frame F;
    F.lds = (LAS unsigned char*)lds_raw; F.ws = args.ws; F.ctl = (unsigned*)(args.ws + WS_CTL);
    F.tid = threadIdx.x; F.lane = F.tid & 63; F.wave = __builtin_amdgcn_readfirstlane(F.tid >> 6);
    F.G = gridDim.x; { const int bx = blockIdx.x; F.vcu = (F.G % 8 == 0) ? (bx % 8) * (F.G / 8) + bx / 8 : bx; }
    for (int u = F.tid; u < (LDS_BYTES - LDSCTL_OFF) / 4; u += 512) ((LAS unsigned*)(F.lds + LDSCTL_OFF))[u] = 0u;
    __syncthreads();
    const int lo = args.ph_lo, hi = args.ph_hi;
    XcdBarrier bar; bar.bar = F.ctl + CW_BAR; bar.x = 0; bar.st = nullptr;
    if (hi - lo > 1) bar = xcd_barrier_post(F.ctl + CW_BAR, (volatile LAS unsigned*)(F.lds + MISC_OFF + 32));
#define REFRESH() do { int t_ = threadIdx.x; asm volatile("" : "+v"(t_)); F.tid = t_; F.lane = t_ & 63; } while (0)
#define IN(k) (lo <= (k) && (k) < hi)
#define SEAM(k) do { if (IN(k) && IN((k) + 1)) xcd_barrier(bar); } while (0)
    unsigned long long pr_t0 = 0, pr_d = 0;
#define PRB0(k) do { if (PROBE_PH == (k) && blockIdx.x == 0) pr_t0 = __builtin_amdgcn_s_memrealtime(); } while (0)
#define PRB1(k) do { if (PROBE_PH == (k) && blockIdx.x == 0) pr_d = __builtin_amdgcn_s_memrealtime() - pr_t0; } while (0)

    PRB0(0);
    if (IN(0)) { REFRESH(); p0_prep(F, args); __syncthreads(); }
    SEAM(0);
    PRB1(0);
    PRB0(1);
    if (IN(1)) { REFRESH();
        pg8::EpiProj E{(bf16_t*)(F.ws + WS_R1), NPROJ, (const float*)(F.ws + WS_WR + 128 * 1024), (const float*)(F.ws + WS_RS1)};
        { pg8::ProjOrder S{0, (int)blockIdx.x, (const char*)(F.ws + WS_R2), (const char*)(F.ws + WS_WIN), D, D};
          pg8::gemm_phase<pg8::EpiProj, pg8::ProjOrder>(F.lds, D, S, E); }
        dep_post(F.ctl + CW_DEP_QK);
        { pg8::ProjOrder S{1, (int)blockIdx.x, (const char*)(F.ws + WS_R2), (const char*)(F.ws + WS_WIN), D, D};
          pg8::gemm_phase<pg8::EpiProj, pg8::ProjOrder>(F.lds, D, S, E); }
        dep_post(F.ctl + CW_DEP_CV);
    }
    PRB1(1);
    PRB0(2);
    if (IN(2)) { REFRESH();
        const int u = F.vcu;
        if (u < 128) { dep_wait(F.ctl + CW_DEP_QK, (unsigned)F.G, F.ctl + CW_BAR); mlstm_unit(F, u); }
        else if (u < 256) {
            dep_wait(F.ctl + CW_DEP_CV, (unsigned)F.G, F.ctl + CW_BAR);
            const int p = u - 128; conv_part(F, args.in[4], p);
            asm volatile("s_waitcnt vmcnt(0)" ::: "memory"); __syncthreads();
            pg8::DenseOrder S{1, D / 256, 1, 0, 512, (const char*)(F.ws + WS_YMC) + ((size_t)p * 256 * D + 512) * 2, (const char*)(F.ws + WS_WOUT) + 512 * 2, D, D};
            pg8::EpiResBf16 E{args.in[0] + (size_t)p * 256 * D, (bf16_t*)(F.ws + WS_X1B) + (size_t)p * 256 * D, D};
            pg8::gemm_phase<pg8::EpiResBf16, pg8::DenseOrder>(F.lds, 512, S, E);
            __syncthreads();
        }
        expert_queue(F, args, false);
    }
    SEAM(2);
    PRB1(2);
    PRB0(3);
    if (IN(3)) { REFRESH();
        pg8::DenseOrder S{NTOK / 256, D / 256, F.G, (int)blockIdx.x, 512, (const char*)(F.ws + WS_YMC), (const char*)(F.ws + WS_WOUT), D, D};
        pg8::EpiAddBf16 E{(const bf16_t*)(F.ws + WS_X1B), (bf16_t*)(F.ws + WS_X1B), D};
        pg8::gemm_phase<pg8::EpiAddBf16, pg8::DenseOrder>(F.lds, 512, S, E);
    }
    SEAM(3);
    PRB1(3);
    PRB0(4);
    if (IN(4)) { REFRESH(); p4_router(F); }
    SEAM(4);
    PRB1(4);
    PRB0(5);
    if (IN(5)) { REFRESH();
        moe_tiles(F);
        const LAS int* tb = (const LAS int*)(F.lds + TB_OFF); const LAS int* cn = (const LAS int*)(F.lds + CNT_OFF);
        constexpr int s1 = 0x01010101 * 127, sw = 0x01010101 * (127 - FP8_W_SHIFT);
        pg8::MoeOrder<true> S{tb[NE], 4, F.G, (int)blockIdx.x, D / 2, (const char*)(F.ws + WS_X1Q), (const char*)(F.ws + WS_W1), (size_t)1024 * 1024, (const int*)(F.ws + WS_LIST), tb, cn, D / 2, D / 2, s1, sw};
        pg8::EpiSwiglu E{(unsigned char*)(F.ws + WS_HBUF), (const float*)(F.ws + WS_LRS)};
        pg8::gemm_phase<pg8::EpiSwiglu, pg8::MoeOrder<true>>(F.lds, D / 2, S, E);
        expert_queue(F, args, true);
    }
    SEAM(5);
    PRB1(5);
    PRB0(6);
    if (IN(6)) { REFRESH();
        moe_tiles(F);
        const LAS int* tb = (const LAS int*)(F.lds + TB_OFF); const LAS int* cn = (const LAS int*)(F.lds + CNT_OFF);
        constexpr int sh = 0x01010101 * (127 - FP8_H_SHIFT), sw = 0x01010101 * (127 - FP8_W_SHIFT);
        pg8::MoeOrder<false> S{tb[NE], 4, F.G, (int)blockIdx.x, DFF / 2, (const char*)(F.ws + WS_HBUF), (const char*)(F.ws + WS_W2), (size_t)1024 * 512, nullptr, tb, cn, DFF / 2, DFF / 2, sh, sw};
        pg8::EpiFp8 E{(unsigned char*)(F.ws + WS_Y2), D};
        pg8::gemm_phase<pg8::EpiFp8, pg8::MoeOrder<false>>(F.lds, DFF / 2, S, E);
    }
    SEAM(6);
    PRB1(6);
    PRB0(7);
    if (IN(7)) { REFRESH(); moe_tiles(F); p7_final(F, args.out, args.in[14]); }
    PRB1(7);
    if (PROBE_PH >= 0 && blockIdx.x == 0) { const unsigned long long t0 = __builtin_amdgcn_s_memrealtime(); while (__builtin_amdgcn_s_memrealtime() - t0 < pr_d) __builtin_amdgcn_s_sleep(8); }
#undef IN
#undef SEAM
}

extern "C" void kernel_launch(void* const* d_in, const int* in_sizes, int n_in, void* d_out, int out_size, void* d_ws, size_t ws_size, hipStream_t stream) {
    static int grid = 0;
    if (grid == 0) {
        if (n_in != 15 || in_sizes[0] != NTOK * D || out_size != NTOK * D || ws_size < WS_END) { fprintf(stderr, "kernel_launch: unexpected shapes / workspace (n_in %d, ws %zu)\n", n_in, ws_size); grid = -1; return; }
        int dev = 0, cus = 0;
        if (hipGetDevice(&dev) != hipSuccess || hipDeviceGetAttribute(&cus, hipDeviceAttributeMultiprocessorCount, dev) != hipSuccess) { grid = -1; return; }
        if (hipFuncSetAttribute((const void*)hymba_fwd, hipFuncAttributeMaxDynamicSharedMemorySize, LDS_BYTES) != hipSuccess) { fprintf(stderr, "kernel_launch: hipFuncSetAttribute failed\n"); grid = -1; return; }
        int per_cu = 0;
        (void)hipOccupancyMaxActiveBlocksPerMultiprocessor(&per_cu, (const void*)hymba_fwd, 512, LDS_BYTES);
        (void)hipGetLastError();
        grid = cus;
    }
    if (grid < 0) return;
    (void)hipMemsetAsync((char*)d_ws + WS_CTL, 0, CTL_ZERO_BYTES, stream);
    Args a{};
    for (int i = 0; i < 15; ++i) a.in[i] = (const float*)d_in[i];
    a.out = (float*)d_out; a.ws = (unsigned char*)d_ws;
    if (MK_N_LAUNCHES == 1) { a.ph_lo = 0; a.ph_hi = NPHASE; hipLaunchKernelGGL(hymba_fwd, dim3(grid), dim3(512), LDS_BYTES, stream, a); }
    else for (int p = 0; p < NPHASE; ++p) { a.ph_lo = p; a.ph_hi = p + 1; hipLaunchKernelGGL(hymba_fwd, dim3(grid), dim3(512), LDS_BYTES, stream, a); }
}
```

```cpp
#include <hip/hip_runtime.h>
#include <cstdio>
#include <cstdint>

#ifndef PROBE_PH
#define PROBE_PH -1
#endif
#ifndef MK_N_LAUNCHES
#define MK_N_LAUNCHES 1
#endif

#define LAS __attribute__((address_space(3)))
#define GAS __attribute__((address_space(1)))
typedef unsigned short bf16_t;
typedef short bf16x8 __attribute__((ext_vector_type(8)));
typedef short s16x4 __attribute__((ext_vector_type(4)));
typedef float f32x4 __attribute__((ext_vector_type(4)));
typedef float f32x2 __attribute__((ext_vector_type(2)));
typedef unsigned u32x4 __attribute__((ext_vector_type(4)));
typedef unsigned u32x2 __attribute__((ext_vector_type(2)));
typedef int i32x8 __attribute__((ext_vector_type(8)));
typedef int i32x4 __attribute__((ext_vector_type(4)));
constexpr int FP8_P_SHIFT = 3;
constexpr int FP8_YM_SHIFT = 2;
constexpr int FP8_W_SHIFT = 5, FP8_H_SHIFT = 3, FP8_Y_SHIFT = 3;

constexpr int NTOK = 32768, D = 1024, SEQ = 4096;
constexpr int NH = 4, DH = 128, CH = 64, NCH = SEQ / CH;
constexpr int NPROJ = 3584, NPROJ_IN = 3592;
constexpr int NE = 32, DFF = 512, LCAP = 32768;
constexpr int MAXTILES = 288;
constexpr float RMS_EPS = 1e-6f;

constexpr size_t MiB = 1u << 20;
constexpr size_t WS_CTL = 0, CTL_ZERO_BYTES = 64 * 1024;
constexpr size_t WS_WIN = 2 * MiB;
constexpr size_t WS_WOUT = 9 * MiB;
constexpr size_t WS_WR = 11 * MiB;
constexpr size_t WS_W1 = 12 * MiB;
constexpr size_t WS_W2 = 76 * MiB;
constexpr size_t WS_LIST = 108 * MiB;
constexpr size_t WS_LRS = 112 * MiB;
constexpr size_t WS_TOKINFO = 116 * MiB;
constexpr size_t WS_RS1 = 117 * MiB;
constexpr size_t WS_GATES = 118 * MiB;
constexpr size_t WS_R2 = 120 * MiB;
constexpr size_t WS_MCHG = 479 * MiB;
constexpr size_t WS_YMC = 44 * MiB;
constexpr size_t WS_R1 = 184 * MiB;
constexpr size_t WS_HBUF = WS_R1, WS_Y2 = WS_R1 + 72 * MiB;
constexpr size_t WS_X1B = 408 * MiB;
constexpr size_t WS_GSC = 472 * MiB;
constexpr size_t WS_X1Q = 44 * MiB;
constexpr size_t WS_END = 480 * MiB;
constexpr int CW_CNT = 64;
constexpr int CW_QUEUE = 128;
constexpr int CW_QUEUE2 = 192;
constexpr int CW_BAR = 4096;
constexpr int CW_DEP_QK = 256, CW_DEP_CV = 320;

constexpr int RING_BYTES = 131072;
constexpr int LDSCTL_OFF = 143360, MISC_OFF = LDSCTL_OFF + 320, TB_OFF = LDSCTL_OFF + 1024, CNT_OFF = LDSCTL_OFF + 1280;
constexpr int LDS_BYTES = 147456;

typedef __bf16 bf16pair_t __attribute__((ext_vector_type(2)));
__device__ __forceinline__ unsigned cvtpk(float lo, float hi) { bf16pair_t v; v[0] = (__bf16)lo; v[1] = (__bf16)hi; return __builtin_bit_cast(unsigned, v); }
__device__ __forceinline__ float bflo(unsigned u) { return __uint_as_float(u << 16); }
__device__ __forceinline__ float bfhi(unsigned u) { return __uint_as_float(u & 0xffff0000u); }
__device__ __forceinline__ float wave_sum(float v) {
#pragma unroll
    for (int o = 1; o < 64; o <<= 1) v += __shfl_xor(v, o);
    return v;
}
#define LDS_WAIT() asm volatile("s_waitcnt lgkmcnt(0)" ::: "memory")

#define PROJ_F8_BYTE(col) (2048 + ((col) - 1024))
namespace pg8 {
constexpr int NTOK_TILES = 128;
constexpr int LDSCTL_TOKL = 143360 + 2048;
constexpr int BM = 256, BK = 64, HALF = 128, HTB = HALF * BK * 2, STAGE_BYTES = 8 * HTB, NXCD = 8, WGM = 8;
__host__ __device__ __forceinline__ int lds_byte(int r, int c) { const int st = (r >> 4) * 2 + (c >> 5), rr = r & 15, cc = c & 31, ob = rr * 64 + cc * 2; return st * 1024 + (ob ^ (((ob >> 9) & 1) << 5)); }
__host__ __device__ __forceinline__ void stage_rc(int b, int& R, int& C) { const int st = b / 1024, sb = b % 1024, swz = sb ^ (((sb >> 9) & 1) << 5); R = (st >> 1) * 16 + swz / 64; C = (st & 1) * 32 + (swz % 64) / 2; }
__host__ __device__ __forceinline__ int perm32(int rho) { const int n = rho >> 4, i = rho & 15; return 8 * (i >> 2) + 4 * n + (i & 3); }

struct Unit { int pm, pn; const char* a; const char* b; int e, mt, cnt; };

__device__ __forceinline__ void tile_of(int L, int nM, int nN, int& pm, int& pn) {
    const int nwg = nM * nN; int wgid = L;
    { const int q = nwg / NXCD, r = nwg % NXCD, xcd = wgid % NXCD, off = wgid / NXCD; wgid = (xcd < r ? xcd * (q + 1) : r * (q + 1) + (xcd - r) * q) + off; }
    const int nig = WGM * nN, gid = wgid / nig, fm = gid * WGM, gsz = (nM - fm) < WGM ? (nM - fm) : WGM;
    pm = fm + ((wgid % nig) % gsz); pn = (wgid % nig) / gsz;
}
struct DenseOrder {
    static constexpr bool GATHER = false, FP8 = false, HOOK = false; static constexpr int sA = 0, sB = 0;
    int nM, nN, G, c, K; const char* A; const char* B; int lda, ldb;
    __device__ __forceinline__ bool next(int i, Unit& u) const {
        const long L = (long)i * G + c; if (L >= (long)nM * nN) return false;
        tile_of((int)L, nM, nN, u.pm, u.pn);
        u.a = A + (size_t)u.pm * BM * lda * 2; u.b = B + (size_t)u.pn * BM * ldb * 2; u.e = 0; u.mt = 0; u.cnt = 0; return true;
    }
    __device__ __forceinline__ void a_off(const Unit&, int, unsigned (&)[2][2], const LAS int* = nullptr) const {}
    __device__ __forceinline__ void prefetch_list(const Unit&, int, LAS int*) const {}
};
struct DenseOrder8 {
    static constexpr bool GATHER = false, FP8 = true, HOOK = false;
    int nM, nN, G, c, K; const char* A; const char* B; int lda, ldb, sA, sB;
    __device__ __forceinline__ bool next(int i, Unit& u) const {
        const long L = (long)i * G + c; if (L >= (long)nM * nN) return false;
        tile_of((int)L, nM, nN, u.pm, u.pn);
        u.a = A + (size_t)u.pm * BM * lda * 2; u.b = B + (size_t)u.pn * BM * ldb * 2; u.e = 0; u.mt = 0; u.cnt = 0; return true;
    }
    __device__ __forceinline__ void a_off(const Unit&, int, unsigned (&)[2][2], const LAS int* = nullptr) const {}
    __device__ __forceinline__ void prefetch_list(const Unit&, int, LAS int*) const {}
};
struct ProjOrder {
    static constexpr bool GATHER = false, FP8 = false, HOOK = true; static constexpr int sA = 0, sB = 0;
    int c, first, n; const char* A; const char* B; int lda, ldb; unsigned* qk; unsigned x; volatile LAS unsigned* st;
    __device__ __forceinline__ bool next(int i0, Unit& u) const {
        if (i0 >= n) return false;
        const int i = first + i0;
        if (i < 4) { const int xx = c & 7, loc = c >> 3, l2 = loc >> 1;
            u.pm = 16 * xx + 4 * i + (l2 & 3); u.pn = ((loc & 1) ? 0 : 4) + (l2 >> 2); }
        else { const int j = i - 4, xx = c & 7, loc = c >> 3; const bool conv = (loc & 1) != 0;
            const int U = (conv ? 0 : 512) + (j * 8 + xx) * 16 + (loc >> 1), g = U / 48, rem = U - 48 * g;
            u.pn = 8 + (rem >> 3); u.pm = 8 * g + (rem & 7); }
        u.a = A + (size_t)u.pm * BM * lda * 2; u.b = B + (size_t)u.pn * BM * ldb * 2; u.e = 0; u.mt = 0; u.cnt = 0; return true;
    }
    __device__ __forceinline__ void a_off(const Unit&, int, unsigned (&)[2][2], const LAS int* = nullptr) const {}
    __device__ __forceinline__ void prefetch_list(const Unit&, int, LAS int*) const {}
    __device__ __forceinline__ void hook(int ui) const {
        if (ui == 4 && threadIdx.x == 0) {
            const unsigned nloc = st[0];
            const unsigned old = __hip_atomic_fetch_add(&qk[x], 1u, __ATOMIC_RELAXED, __HIP_MEMORY_SCOPE_AGENT);
            const bool last = old + 1u == nloc;
            if (last) __builtin_amdgcn_fence(__ATOMIC_RELEASE, "agent");
            st[8] = last ? 1u : 0u;
        }
    }
    __device__ __forceinline__ void hook2(int ui) const {
        if (ui == 4 && threadIdx.x == 0 && st[8] != 0u) { asm volatile("s_waitcnt vmcnt(0)" ::: "memory"); (void)__hip_atomic_fetch_add(&qk[16], 1u, __ATOMIC_RELAXED, __HIP_MEMORY_SCOPE_AGENT); }
    }
};
template <bool GATHER_>
struct MoeOrder {
    static constexpr bool GATHER = GATHER_, FP8 = true, HOOK = false;
    int nM, nN, G, c, K; const char* A; const char* B; size_t b_estride; const int* list; const LAS int* tb; const LAS int* cn; int lda, ldb, sA, sB;
    __device__ __forceinline__ bool next(int i, Unit& u) const {
        const long L = (long)i * G + c; if (L >= (long)nM * nN) return false;
        tile_of((int)L, nM, nN, u.pm, u.pn);
        int e = 0;
#pragma unroll
        for (int j = 1; j < NE; ++j) e += (tb[j] <= u.pm) ? 1 : 0;
        e = __builtin_amdgcn_readfirstlane(e);
        u.e = e; u.mt = u.pm - __builtin_amdgcn_readfirstlane(tb[e]); u.cnt = __builtin_amdgcn_readfirstlane(cn[e]);
        u.b = B + (size_t)e * b_estride + (size_t)u.pn * BM * ldb * 2;
        u.a = GATHER ? A : A + (size_t)u.pm * BM * lda * 2; return true;
    }
    __device__ __forceinline__ void a_off(const Unit& u, int tid, unsigned (&off)[2][2], const LAS int* tokl = nullptr) const {
        if constexpr (GATHER) {
            asm volatile("" : "+v"(tid));
#pragma unroll
            for (int i = 0; i < 2; ++i) { int R, C; stage_rc(tid * 16 + i * 8192, R, C);
#pragma unroll
                for (int h = 0; h < 2; ++h) { int tok;
                    if (tokl) tok = tokl[R + h * HALF];
                    else { int idx = u.mt * BM + R + h * HALF; idx = idx < u.cnt ? idx : u.mt * BM; tok = list[(size_t)u.e * LCAP + idx]; }
                    off[h][i] = (unsigned)tok * (unsigned)(lda * 2) + (unsigned)C * 2u; } }
        }
    }
    __device__ __forceinline__ void prefetch_list(const Unit& u, int, LAS int* tokl) const {
        if constexpr (GATHER) {
            int t2 = threadIdx.x; asm volatile("" : "+v"(t2));
            const int w2 = __builtin_amdgcn_readfirstlane(t2 >> 6);
            if (w2 < 4) { int idx = u.mt * BM + t2; idx = idx < u.cnt ? idx : u.mt * BM;
                __builtin_amdgcn_global_load_lds((const unsigned*)(list + (size_t)u.e * LCAP + idx), (LAS unsigned*)(tokl + w2 * 64), 4, 0, 0); }
        }
    }
};

__device__ __forceinline__ unsigned cvt_pk_bf16(float lo, float hi) { return cvtpk(lo, hi); }

struct EpiProj {
    static constexpr int PERM = 2;
    bf16_t* O; int ldc; const float* bias; const float* rowscale;
    __device__ __forceinline__ void operator()(const f32x4 (&acc)[2][2][4][2], const Unit& u, int wr, int wc, int fr, int fq) const {
        asm volatile("" : "+v"(fr));
        const int row0 = u.pm * BM + wr * 64 + fr, col0 = u.pn * BM + wc * 64 + 16 * fq;
        const bool f8 = u.pn >= 4;
        f32x4 bv[2][2];
#pragma unroll
        for (int bj = 0; bj < 2; ++bj)
#pragma unroll
            for (int n = 0; n < 2; ++n) bv[bj][n] = *(const f32x4*)(bias + col0 + 8 * bj + 4 * n);
        float scv[2][4];
#pragma unroll
        for (int ai = 0; ai < 2; ++ai)
#pragma unroll
            for (int m = 0; m < 4; ++m) scv[ai][m] = rowscale[row0 + ai * HALF + m * 16];
#pragma unroll
        for (int ai = 0; ai < 2; ++ai)
#pragma unroll
            for (int m = 0; m < 4; ++m) { const int row = row0 + ai * HALF + m * 16; const float sc = scv[ai][m]; bf16_t* rowb = O + (size_t)row * ldc;
                if (f8) {
                    const float ps = (float)(1 << FP8_P_SHIFT); unsigned wv[4];
#pragma unroll
                    for (int bj = 0; bj < 2; ++bj)
#pragma unroll
                        for (int n = 0; n < 2; ++n) { f32x4 v = (acc[ai][bj][m][n] * sc + bv[bj][n]) * ps;
#pragma unroll
                            for (int j = 0; j < 4; ++j) v[j] = __builtin_amdgcn_fmed3f(v[j], -448.f, 448.f);
                            unsigned w = (unsigned)__builtin_amdgcn_cvt_pk_fp8_f32(v[0], v[1], 0, false); w = (unsigned)__builtin_amdgcn_cvt_pk_fp8_f32(v[2], v[3], (int)w, true); wv[bj * 2 + n] = w; }
                    *(u32x4*)((unsigned char*)rowb + PROJ_F8_BYTE(col0)) = (u32x4){wv[0], wv[1], wv[2], wv[3]};
                } else {
#pragma unroll
                    for (int bj = 0; bj < 2; ++bj) { const f32x4 v0 = acc[ai][bj][m][0] * sc + bv[bj][0], v1 = acc[ai][bj][m][1] * sc + bv[bj][1];
                        u32x4 w; w.x = cvt_pk_bf16(v0[0], v0[1]); w.y = cvt_pk_bf16(v0[2], v0[3]); w.z = cvt_pk_bf16(v1[0], v1[1]); w.w = cvt_pk_bf16(v1[2], v1[3]);
                        *(u32x4*)(rowb + col0 + 8 * bj) = w; }
                } }
    }
};
struct EpiResBf16 {
    static constexpr bool PERM = true;
    const float* base; bf16_t* O; int ldc;
    __device__ __forceinline__ void operator()(const f32x4 (&acc)[2][2][4][2], const Unit& u, int wr, int wc, int fr, int fq) const {
        asm volatile("" : "+v"(fr));
        const int row0 = u.pm * BM + wr * 64 + fr, col0 = u.pn * BM + wc * 32 + 8 * fq;
#pragma unroll
        for (int ai = 0; ai < 2; ++ai) {
            f32x4 bb[4][2][2];
#pragma unroll
            for (int m = 0; m < 4; ++m) { const size_t off = (size_t)(row0 + ai * HALF + m * 16) * ldc + col0;
#pragma unroll
                for (int bj = 0; bj < 2; ++bj) { bb[m][bj][0] = *(const f32x4*)(base + off + bj * HALF); bb[m][bj][1] = *(const f32x4*)(base + off + bj * HALF + 4); } }
#pragma unroll
            for (int m = 0; m < 4; ++m) { const size_t off = (size_t)(row0 + ai * HALF + m * 16) * ldc + col0;
#pragma unroll
                for (int bj = 0; bj < 2; ++bj) { const f32x4 v0 = acc[ai][bj][m][0] + bb[m][bj][0], v1 = acc[ai][bj][m][1] + bb[m][bj][1];
                    u32x4 w; w.x = cvt_pk_bf16(v0[0], v0[1]); w.y = cvt_pk_bf16(v0[2], v0[3]); w.z = cvt_pk_bf16(v1[0], v1[1]); w.w = cvt_pk_bf16(v1[2], v1[3]);
                    *(u32x4*)(O + off + bj * HALF) = w; } }
        }
    }
};
struct EpiAddBf16 {
    static constexpr bool PERM = true;
    const bf16_t* base; bf16_t* O; int ldc;
    __device__ __forceinline__ void operator()(const f32x4 (&acc)[2][2][4][2], const Unit& u, int wr, int wc, int fr, int fq) const {
        asm volatile("" : "+v"(fr));
        const int row0 = u.pm * BM + wr * 64 + fr, col0 = u.pn * BM + wc * 32 + 8 * fq;
        u32x4 bb[2][4][2];
#pragma unroll
        for (int ai = 0; ai < 2; ++ai)
#pragma unroll
            for (int m = 0; m < 4; ++m) { const size_t off = (size_t)(row0 + ai * HALF + m * 16) * ldc + col0;
#pragma unroll
                for (int bj = 0; bj < 2; ++bj) bb[ai][m][bj] = __builtin_nontemporal_load((const u32x4*)(base + off + bj * HALF));     }
#pragma unroll
        for (int ai = 0; ai < 2; ++ai)
#pragma unroll
            for (int m = 0; m < 4; ++m) { const size_t off = (size_t)(row0 + ai * HALF + m * 16) * ldc + col0;
#pragma unroll
                for (int bj = 0; bj < 2; ++bj) { const u32x4 b = bb[ai][m][bj];
                    const f32x4 v0 = acc[ai][bj][m][0], v1 = acc[ai][bj][m][1];
                    u32x4 w; w.x = cvt_pk_bf16(v0[0] + bflo(b.x), v0[1] + bfhi(b.x)); w.y = cvt_pk_bf16(v0[2] + bflo(b.y), v0[3] + bfhi(b.y));
                    w.z = cvt_pk_bf16(v1[0] + bflo(b.z), v1[1] + bfhi(b.z)); w.w = cvt_pk_bf16(v1[2] + bflo(b.w), v1[3] + bfhi(b.w));
                    *(u32x4*)(O + off + bj * HALF) = w; } }
    }
};
struct EpiSwiglu {
    static constexpr bool PERM = true;
    unsigned char* H; const float* lrs;
    __device__ __forceinline__ void operator()(const f32x4 (&acc)[2][2][4][2], const Unit& u, int wr, int wc, int fr, int fq) const {
        asm volatile("" : "+v"(fr));
        float scv[2][4];
#pragma unroll
        for (int ai = 0; ai < 2; ++ai)
#pragma unroll
            for (int m = 0; m < 4; ++m) { const int idx = u.mt * BM + ai * HALF + wr * 64 + m * 16 + fr; scv[ai][m] = lrs[(size_t)u.e * LCAP + (idx < u.cnt ? idx : u.mt * BM)]; }
#pragma unroll
        for (int ai = 0; ai < 2; ++ai)
#pragma unroll
            for (int m = 0; m < 4; ++m) { const int rl = ai * HALF + wr * 64 + m * 16 + fr;
                const float sc = scv[ai][m], nsc = sc * -1.4426950408889634f, sc3 = sc * sc * (float)(1 << FP8_H_SHIFT);
                unsigned char* rowp = H + (size_t)(u.pm * BM + rl) * DFF + u.pn * HALF + wc * 32 + 8 * fq;
                f32x4 hv[2];
#pragma unroll
                for (int n = 0; n < 2; ++n) { const f32x4 ag = acc[ai][0][m][n], au = acc[ai][1][m][n]; const f32x4 t = ag * nsc; f32x4 d;
#pragma unroll
                    for (int j = 0; j < 4; ++j) d[j] = __builtin_amdgcn_exp2f(t[j]);
                    d = d + 1.0f;
#pragma unroll
                    for (int j = 0; j < 4; ++j) d[j] = __builtin_amdgcn_rcpf(d[j]);
                    hv[n] = (ag * au) * sc3 * d; }
                u32x2 w;
                w.x = (unsigned)__builtin_amdgcn_cvt_pk_fp8_f32(hv[0][0], hv[0][1], 0, false); w.x = (unsigned)__builtin_amdgcn_cvt_pk_fp8_f32(hv[0][2], hv[0][3], (int)w.x, true);
                w.y = (unsigned)__builtin_amdgcn_cvt_pk_fp8_f32(hv[1][0], hv[1][1], 0, false); w.y = (unsigned)__builtin_amdgcn_cvt_pk_fp8_f32(hv[1][2], hv[1][3], (int)w.y, true);
                *(u32x2*)rowp = w; }
    }
};
struct EpiFp8 {
    static constexpr int PERM = 2;
    unsigned char* O; int ldc;
    __device__ __forceinline__ void operator()(const f32x4 (&acc)[2][2][4][2], const Unit& u, int wr, int wc, int fr, int fq) const {
        asm volatile("" : "+v"(fr));
        const int row0 = u.pm * BM + wr * 64 + fr, col0 = u.pn * BM + wc * 64 + 16 * fq; const float ys = (float)(1 << FP8_Y_SHIFT);
#pragma unroll
        for (int ai = 0; ai < 2; ++ai)
#pragma unroll
            for (int m = 0; m < 4; ++m) { unsigned char* rowp = O + (size_t)(row0 + ai * HALF + m * 16) * ldc + col0;
                unsigned wv[4];
#pragma unroll
                for (int bj = 0; bj < 2; ++bj)
#pragma unroll
                    for (int n = 0; n < 2; ++n) { const f32x4 v = acc[ai][bj][m][n] * ys;
                        unsigned w = (unsigned)__builtin_amdgcn_cvt_pk_fp8_f32(v[0], v[1], 0, false); w = (unsigned)__builtin_amdgcn_cvt_pk_fp8_f32(v[2], v[3], (int)w, true); wv[bj * 2 + n] = w; }
                *(u32x4*)rowp = (u32x4){wv[0], wv[1], wv[2], wv[3]}; }
    }
};
struct EpiBf16 {
    static constexpr bool PERM = true;
    bf16_t* O; int ldc;
    __device__ __forceinline__ void operator()(const f32x4 (&acc)[2][2][4][2], const Unit& u, int wr, int wc, int fr, int fq) const {
        asm volatile("" : "+v"(fr));
        const int row0 = u.pm * BM + wr * 64 + fr, col0 = u.pn * BM + wc * 32 + 8 * fq;
#pragma unroll
        for (int ai = 0; ai < 2; ++ai)
#pragma unroll
            for (int m = 0; m < 4; ++m) { bf16_t* rowp = O + (size_t)(row0 + ai * HALF + m * 16) * ldc + col0;
#pragma unroll
                for (int bj = 0; bj < 2; ++bj) { const f32x4 v0 = acc[ai][bj][m][0], v1 = acc[ai][bj][m][1];
                    u32x4 w; w.x = cvt_pk_bf16(v0[0], v0[1]); w.y = cvt_pk_bf16(v0[2], v0[3]); w.z = cvt_pk_bf16(v1[0], v1[1]); w.w = cvt_pk_bf16(v1[2], v1[3]);
                    *(u32x4*)(rowp + bj * HALF) = w; } }
    }
};

template <class Epi, class Sched>
__device__ __forceinline__ void gemm_phase(LAS unsigned char* lds, const int K, const Sched& S, const Epi& E) {
    const int tid = threadIdx.x, wid = __builtin_amdgcn_readfirstlane(tid >> 6), lane = tid & 63, wr = wid >> 2, wc = wid & 3, fr = lane & 15, fq = lane >> 4;
    const int nt = K / BK;
    unsigned voffB[2]; unsigned ah[2][2], c1[2];
#pragma unroll
    for (int i = 0; i < 2; ++i) { int R, C; stage_rc(tid * 16 + i * 8192, R, C); const int Rb = (int)Epi::PERM == 2 ? (64 * (R >> 5) + 16 * ((R >> 2) & 3) + 4 * ((R >> 4) & 1) + (R & 3)) : Epi::PERM ? ((R & ~31) + perm32(R & 31)) : R;
        voffB[i] = (unsigned)(Rb * S.ldb + C) * 2u;
#pragma unroll
        for (int h = 0; h < 2; ++h) ah[h][i] = (unsigned)((R + h * HALF) * S.lda + C) * 2u; }
    const size_t kstep = (size_t)(BK * 2);
    const size_t hstep = (size_t)((int)Epi::PERM == 2 ? 8 : HALF) * S.ldb * 2;
    const unsigned ldsw = (unsigned)wid * 1024u;
    const int aoff = lds_byte(wr * 64 + fr, fq * 8), boff = lds_byte(wc * 32 + fr, fq * 8);
#define PG8_SA(b, h) (((b) * 2 + (h)) * HTB)
#define PG8_SB(b, h) ((4 + (b) * 2 + (h)) * HTB)
#define PG8_STAGE(bufoff, gbase, voff) do { _Pragma("unroll") for (int _i = 0; _i < 2; ++_i) \
        __builtin_amdgcn_global_load_lds((const unsigned*)((const char*)(gbase) + (voff)[_i]), (LAS unsigned*)(lds + (bufoff) + ldsw + _i * 8192), 16, 0, 0); } while (0)
#define PG8_LD16(off) (*(const LAS bf16x8*)(lds + (off)))
#define PG8_LD8(off) (*(const LAS i32x4*)(lds + (off)))
#define PG8_LDA(dst, b, h) do { _Pragma("unroll") for (int m = 0; m < 4; ++m) { if constexpr (Sched::FP8) { const i32x4 lo_ = PG8_LD8(PG8_SA(b, h) + aoff + m * 2048), hi_ = PG8_LD8(PG8_SA(b, h) + aoff + m * 2048 + 1024); \
            dst##8[m] = (i32x8){lo_[0], lo_[1], lo_[2], lo_[3], hi_[0], hi_[1], hi_[2], hi_[3]}; } else { _Pragma("unroll") for (int k = 0; k < 2; ++k) dst[m][k] = PG8_LD16(PG8_SA(b, h) + aoff + m * 2048 + k * 1024); } } } while (0)
#define PG8_LDB(dst, b, h) do { _Pragma("unroll") for (int n = 0; n < 2; ++n) { if constexpr (Sched::FP8) { const i32x4 lo_ = PG8_LD8(PG8_SB(b, h) + boff + n * 2048), hi_ = PG8_LD8(PG8_SB(b, h) + boff + n * 2048 + 1024); \
            dst##8[n] = (i32x8){lo_[0], lo_[1], lo_[2], lo_[3], hi_[0], hi_[1], hi_[2], hi_[3]}; } else { _Pragma("unroll") for (int k = 0; k < 2; ++k) dst[n][k] = PG8_LD16(PG8_SB(b, h) + boff + n * 2048 + k * 1024); } } } while (0)
#define PG8_MMA16(ai, bj, At, Bt) do { __builtin_amdgcn_s_setprio(1); _Pragma("unroll") for (int m = 0; m < 4; ++m) _Pragma("unroll") for (int n = 0; n < 2; ++n) _Pragma("unroll") for (int k = 0; k < 2; ++k) \
        acc[ai][bj][m][n] = __builtin_amdgcn_mfma_f32_16x16x32_bf16(Bt[n][k], At[m][k], acc[ai][bj][m][n], 0, 0, 0); __builtin_amdgcn_s_setprio(0); } while (0)
#define PG8_MMA8(ai, bj, At, Bt) do { __builtin_amdgcn_s_setprio(1); _Pragma("unroll") for (int m = 0; m < 4; ++m) _Pragma("unroll") for (int n = 0; n < 2; ++n) \
        asm volatile("v_mfma_scale_f32_16x16x128_f8f6f4 %0, %1, %2, %0, %3, %3 op_sel:[0,1,0] op_sel_hi:[0,0,0]" : "+v"(acc[ai][bj][m][n]) : "v"(Bt##8[n]), "v"(At##8[m]), "v"(scv)); __builtin_amdgcn_s_setprio(0); } while (0)
#define PG8_MMA(ai, bj, At, Bt) do { if constexpr (Sched::FP8) PG8_MMA8(ai, bj, At, Bt); else PG8_MMA16(ai, bj, At, Bt); } while (0)
#define PG8_WAIT_V(n) asm volatile("s_waitcnt vmcnt(" #n ")" ::: "memory")
#define PG8_WAIT_L(n) asm volatile("s_waitcnt lgkmcnt(" #n ")" ::: "memory")
#define PG8_BAR __builtin_amdgcn_s_barrier()
#define PG8_SCHED __builtin_amdgcn_sched_barrier(0)
    Unit cur, nxt; int ui = 0;
    if (!S.next(0, cur)) return;
    f32x4 acc[2][2][4][2];
#pragma unroll
    for (int a = 0; a < 2; ++a)
#pragma unroll
        for (int b = 0; b < 2; ++b)
#pragma unroll
            for (int m = 0; m < 4; ++m)
#pragma unroll
                for (int n = 0; n < 2; ++n) acc[a][b][m][n] = (f32x4){0.f, 0.f, 0.f, 0.f};
    const int scv = (S.sB & 0xff) | ((S.sA & 0xff) << 8);
    bf16x8 At[4][2], B0[2][2], B1[2][2]; i32x8 At8[4], B08[2], B18[2];
    const char* cA = cur.a; const char* cB = cur.b;
    PG8_STAGE(PG8_SB(0, 0), cB, voffB); PG8_STAGE(PG8_SB(0, 1), cB + hstep, voffB);
    if constexpr (Sched::GATHER) { S.a_off(cur, tid, ah); }
    c1[0] = ah[1][0]; c1[1] = ah[1][1];
    PG8_STAGE(PG8_SA(0, 0), cA, ah[0]); PG8_STAGE(PG8_SA(0, 1), cA, ah[1]);
    if (wr == 1) PG8_BAR;
    PG8_WAIT_V(2); PG8_BAR;
    PG8_STAGE(PG8_SB(1, 0), cB + kstep, voffB); PG8_STAGE(PG8_SA(1, 0), cA + kstep, ah[0]); PG8_STAGE(PG8_SB(1, 1), cB + hstep + kstep, voffB);
    PG8_WAIT_V(6); PG8_BAR;
    for (;;) {
        const bool has_next = S.next(ui + 1, nxt);
        if constexpr (Sched::GATHER) { if (has_next) S.prefetch_list(nxt, tid, (LAS int*)(lds + LDSCTL_TOKL)); }
        const char* nA = has_next ? nxt.a : cA; const char* nB = has_next ? nxt.b : cB;
        for (int t = 0; t < nt; t += 2) {
            const bool last = (t == nt - 2);
            const char* a1 = cA + (size_t)(t + 1) * kstep;
            const char* a2 = last ? nA : cA + (size_t)(t + 2) * kstep; const char* b2 = last ? nB : cB + (size_t)(t + 2) * kstep;
            const char* a3 = a2 + kstep; const char* b3 = b2 + kstep;
            if constexpr (Sched::GATHER) { if (last && has_next) S.a_off(nxt, tid, ah, (const LAS int*)(lds + LDSCTL_TOKL)); }
            PG8_LDB(B0, 0, 0); PG8_LDB(B1, 0, 1); PG8_SCHED; PG8_LDA(At, 0, 0); PG8_STAGE(PG8_SA(1, 1), a1, c1);
            PG8_WAIT_V(8); PG8_WAIT_L(0); PG8_BAR; PG8_MMA(0, 0, At, B0); PG8_MMA(0, 1, At, B1); PG8_BAR; PG8_SCHED;
            PG8_LDA(At, 0, 1); PG8_STAGE(PG8_SB(0, 0), b2, voffB); PG8_STAGE(PG8_SB(0, 1), b2 + hstep, voffB); PG8_STAGE(PG8_SA(0, 0), a2, ah[0]);
            PG8_WAIT_V(8); PG8_WAIT_L(0); PG8_BAR; PG8_MMA(1, 0, At, B0); PG8_MMA(1, 1, At, B1); PG8_BAR; PG8_SCHED;
            PG8_LDB(B0, 1, 0); PG8_LDB(B1, 1, 1); PG8_SCHED; PG8_LDA(At, 1, 0); PG8_STAGE(PG8_SA(0, 1), a2, ah[1]);
            PG8_WAIT_V(8); PG8_WAIT_L(0); PG8_BAR; PG8_MMA(0, 0, At, B0); PG8_MMA(0, 1, At, B1); PG8_BAR; PG8_SCHED;
            PG8_LDA(At, 1, 1); PG8_STAGE(PG8_SB(1, 0), b3, voffB); PG8_STAGE(PG8_SB(1, 1), b3 + hstep, voffB); PG8_STAGE(PG8_SA(1, 0), a3, ah[0]);
            PG8_WAIT_V(8); PG8_WAIT_L(0); PG8_BAR; PG8_MMA(1, 0, At, B0); PG8_MMA(1, 1, At, B1); PG8_BAR; PG8_SCHED;
        }
        if constexpr (Sched::FP8) asm volatile("s_nop 15\n\ts_nop 15" ::: "memory");
        if (wr == 0) PG8_BAR;
        if constexpr (Sched::HOOK) S.hook(ui);
        E(acc, cur, wr, wc, fr, fq);
        if constexpr (Sched::HOOK) S.hook2(ui);
        if (!has_next) break;
#pragma unroll
        for (int a = 0; a < 2; ++a)
#pragma unroll
            for (int b = 0; b < 2; ++b)
#pragma unroll
                for (int m = 0; m < 4; ++m)
#pragma unroll
                    for (int n = 0; n < 2; ++n) acc[a][b][m][n] = (f32x4){0.f, 0.f, 0.f, 0.f};
        cur = nxt; cA = nA; cB = nB; ++ui;
        c1[0] = ah[1][0]; c1[1] = ah[1][1];
        if (wr == 1) PG8_BAR;
    }
    PG8_WAIT_V(0);
    PG8_BAR;
#undef PG8_SA
#undef PG8_SB
#undef PG8_STAGE
#undef PG8_LDA
#undef PG8_LD16
#undef PG8_LD8
#undef PG8_MMA16
#undef PG8_MMA8
#undef PG8_LDB
#undef PG8_MMA
#undef PG8_WAIT_V
#undef PG8_WAIT_L
#undef PG8_BAR
#undef PG8_SCHED
}
}

#define XB_TMO      128
#define XB_XCNT(j)  (256  + 64 * (j))
#define XB_XSUB(j)  (1280 + 64 * (j))
#define XB_XGEN(j)  (2304 + 64 * (j))
#define XB_TOP      3328
#define XB_TOPGEN   3392
#define XCD_BAR_WORDS 3456
#define XB_SPIN_CAP (1u << 18)
__device__ __forceinline__ unsigned xb_ld(unsigned* p)              { return __hip_atomic_load(p, __ATOMIC_RELAXED, __HIP_MEMORY_SCOPE_AGENT); }
__device__ __forceinline__ unsigned xb_add(unsigned* p, unsigned v) { return __hip_atomic_fetch_add(p, v, __ATOMIC_RELAXED, __HIP_MEMORY_SCOPE_AGENT); }
__device__ __forceinline__ unsigned xb_xcc_id() { return (unsigned)__builtin_amdgcn_s_getreg((3 << 11) | 20) & 0xFu; }
#define XB_SPIN(cond, bar) do { unsigned _sp = 0; while (cond) { __builtin_amdgcn_s_sleep(1); \
    if ((++_sp & 255u) == 0u) { if (xb_ld(&(bar)[XB_TMO])) break; if (_sp > XB_SPIN_CAP) { atomicAdd(&(bar)[XB_TMO], 1u); break; } } } } while (0)
struct XcdBarrier { unsigned* bar; unsigned x; volatile LAS unsigned* st; };
__device__ __forceinline__ XcdBarrier xcd_barrier_post(unsigned* bar, volatile LAS unsigned* st) {
    XcdBarrier b; b.bar = bar; b.x = xb_xcc_id(); b.st = st;
    if (threadIdx.x == 0) (void)xb_add(&bar[XB_XCNT(b.x)], 1u);
    return b;
}
__device__ __forceinline__ void xcd_barrier_complete(unsigned* bar, unsigned x, unsigned& nloc, unsigned& nx) {
    const unsigned G = gridDim.x * gridDim.y * gridDim.z;
    unsigned sum, cnt, mine, sp = 0u;
    for (;;) {
        sum = 0u; cnt = 0u; mine = 0u;
#pragma unroll
        for (unsigned j = 0; j < 16; ++j) { const unsigned c = xb_ld(&bar[XB_XCNT(j)]); sum += c; cnt += (c > 0u) ? 1u : 0u; mine = (j == x) ? c : mine; }
        if (sum == G) break;
        __builtin_amdgcn_s_sleep(1);
        if ((++sp & 255u) == 0u) { if (xb_ld(&bar[XB_TMO])) break; if (sp > XB_SPIN_CAP) { atomicAdd(&bar[XB_TMO], 1u); break; } }
    }
    nloc = mine > 0u ? mine : 1u; nx = cnt > 0u ? cnt : 1u;
}
__device__ __forceinline__ void xcd_barrier(const XcdBarrier& b) {
    asm volatile("s_waitcnt vmcnt(0)" ::: "memory");
    __syncthreads();
    if (threadIdx.x == 0) {
        unsigned* bar = b.bar;
        __builtin_amdgcn_s_waitcnt(0);
        unsigned nloc = b.st[0], nx = b.st[1];
        if (nloc == 0u) { xcd_barrier_complete(bar, b.x, nloc, nx); b.st[0] = nloc; b.st[1] = nx; }
        const unsigned old = xb_add(&bar[XB_XSUB(b.x)], 1u);
        const unsigned gen = old / nloc;
        if (old + 1u == (gen + 1u) * nloc) {
            __builtin_amdgcn_fence(__ATOMIC_RELEASE, "agent");
            asm volatile("s_waitcnt vmcnt(0)" ::: "memory");
            const unsigned og = xb_add(&bar[XB_TOP], 1u);
            const unsigned tg = og / nx;
            if (og + 1u == (tg + 1u) * nx) xb_add(&bar[XB_TOPGEN], 1u);
            else XB_SPIN(xb_ld(&bar[XB_TOPGEN]) == tg, bar);
            __builtin_amdgcn_fence(__ATOMIC_ACQUIRE, "agent");
            xb_add(&bar[XB_XGEN(b.x)], 1u);
            asm volatile("s_waitcnt vmcnt(0)" ::: "memory");
        } else {
            XB_SPIN(xb_ld(&bar[XB_XGEN(b.x)]) == gen, bar);
            __builtin_amdgcn_fence(__ATOMIC_ACQUIRE, "agent");
            asm volatile("s_waitcnt vmcnt(0)" ::: "memory");
        }
    }
    __syncthreads();
}

__device__ __forceinline__ void dep_post(const XcdBarrier& b, unsigned* w) {
    asm volatile("s_waitcnt vmcnt(0)" ::: "memory");
    __syncthreads();
    if (threadIdx.x == 0) {
        const unsigned nloc = b.st[0];
        const unsigned old = xb_add(&w[b.x], 1u);
        if (old + 1u == nloc) { __builtin_amdgcn_fence(__ATOMIC_RELEASE, "agent"); asm volatile("s_waitcnt vmcnt(0)" ::: "memory"); (void)xb_add(&w[16], 1u); }
    }
}
__device__ __forceinline__ void dep_wait(const XcdBarrier& b, unsigned* w) {
    if (threadIdx.x == 0) { const unsigned nx = b.st[1]; XB_SPIN(xb_ld(&w[16]) < nx, b.bar); __builtin_amdgcn_fence(__ATOMIC_ACQUIRE, "agent"); asm volatile("s_waitcnt vmcnt(0)" ::: "memory"); }
    __syncthreads();
}

struct Args {
    const float* in[15]; float* out; unsigned char* ws; int ph_lo, ph_hi;
};
struct Frame {
    LAS unsigned char* lds; unsigned* ctl; unsigned char* ws;
    int tid, lane, wave, vcu, G;
};

template <bool F8>
__device__ __forceinline__ void p0_transpose_item(const float* W, int ldw, int srccol0, const float* ks, float cs, void* WTv, int K, int dstrow0, int k0, LAS float* scr, int lane) {
    float t[32];
#pragma unroll
    for (int i = 0; i < 32; ++i) { const int kk = 2 * i + (lane >> 5); t[i] = __builtin_nontemporal_load(W + (size_t)(k0 + kk) * ldw + srccol0 + (lane & 31)); }
    if (ks) {
        float kv[32];
#pragma unroll
        for (int i = 0; i < 32; ++i) kv[i] = ks[k0 + 2 * i + (lane >> 5)];
        asm volatile("" ::: "memory");
#pragma unroll
        for (int i = 0; i < 32; ++i) t[i] *= kv[i];
    }
    asm volatile("" ::: "memory");
#pragma unroll
    for (int i = 0; i < 32; ++i) { const int kk = 2 * i + (lane >> 5); scr[kk * 33 + (lane & 31)] = t[i] * cs; }
    LDS_WAIT(); asm volatile("" ::: "memory");
    const int c = lane & 7;
#pragma unroll
    for (int j = 0; j < 4; ++j) { const int n = (lane >> 3) + 8 * j; const LAS float* sp = scr + (8 * c) * 33 + n;
        if constexpr (F8) {
            u32x2 o;
            o.x = (unsigned)__builtin_amdgcn_cvt_pk_fp8_f32(sp[0 * 33], sp[1 * 33], 0, false); o.x = (unsigned)__builtin_amdgcn_cvt_pk_fp8_f32(sp[2 * 33], sp[3 * 33], (int)o.x, true);
            o.y = (unsigned)__builtin_amdgcn_cvt_pk_fp8_f32(sp[4 * 33], sp[5 * 33], 0, false); o.y = (unsigned)__builtin_amdgcn_cvt_pk_fp8_f32(sp[6 * 33], sp[7 * 33], (int)o.y, true);
            *(u32x2*)((unsigned char*)WTv + (size_t)(dstrow0 + n) * K + k0 + 8 * c) = o;
        } else {
            u32x4 o; o.x = cvtpk(sp[0 * 33], sp[1 * 33]); o.y = cvtpk(sp[2 * 33], sp[3 * 33]); o.z = cvtpk(sp[4 * 33], sp[5 * 33]); o.w = cvtpk(sp[6 * 33], sp[7 * 33]);
            *(u32x4*)((bf16_t*)WTv + (size_t)(dstrow0 + n) * K + k0 + 8 * c) = o;
        } }
    LDS_WAIT(); asm volatile("" ::: "memory");
}

template <int RW>
__device__ __forceinline__ void p0_rows(const f32x4 (&v)[RW][4], int m0, const LAS float* wgs, bf16_t* xb, float* gbuf, float* rs1, float bgate, int lane) {
    float ss[RW], gd[RW][8];
#pragma unroll
    for (int rr = 0; rr < RW; ++rr) { ss[rr] = 0.f;
#pragma unroll
        for (int j = 0; j < 4; ++j) ss[rr] += (v[rr][j].x * v[rr][j].x + v[rr][j].y * v[rr][j].y) + (v[rr][j].z * v[rr][j].z + v[rr][j].w * v[rr][j].w);
#pragma unroll
        for (int g = 0; g < 8; ++g) gd[rr][g] = 0.f; }
#pragma unroll
    for (int g = 0; g < 8; ++g)
#pragma unroll
        for (int j = 0; j < 4; ++j) { const f32x4 w = *(const LAS f32x4*)(wgs + g * 1024 + 256 * j + 4 * lane);
#pragma unroll
            for (int rr = 0; rr < RW; ++rr) gd[rr][g] += (v[rr][j].x * w.x + v[rr][j].y * w.y) + (v[rr][j].z * w.z + v[rr][j].w * w.w); }
#pragma unroll
    for (int rr = 0; rr < RW; ++rr) {
        u32x2* o8 = (u32x2*)(xb + (size_t)(m0 + rr) * D) + lane;
#pragma unroll
        for (int j = 0; j < 4; ++j) { u32x2 w; w.x = cvtpk(v[rr][j].x, v[rr][j].y); w.y = cvtpk(v[rr][j].z, v[rr][j].w); __hip_atomic_store((unsigned long long*)(o8 + 64 * j), (unsigned long long)w.x | ((unsigned long long)w.y << 32), __ATOMIC_RELAXED, __HIP_MEMORY_SCOPE_AGENT); }
        const float st = wave_sum(ss[rr]);
        const float rs = 1.0f / sqrtf(st * (1.0f / D) + RMS_EPS);
        float a4[4], a2[2], a1;
        const bool h5 = (lane & 32) != 0, h4 = (lane & 16) != 0, h3 = (lane & 8) != 0;
#pragma unroll
        for (int i = 0; i < 4; ++i) { const float keep = h5 ? gd[rr][4 + i] : gd[rr][i], send = h5 ? gd[rr][i] : gd[rr][4 + i]; a4[i] = keep + __shfl_xor(send, 32); }
#pragma unroll
        for (int i = 0; i < 2; ++i) { const float keep = h4 ? a4[2 + i] : a4[i], send = h4 ? a4[i] : a4[2 + i]; a2[i] = keep + __shfl_xor(send, 16); }
        { const float keep = h3 ? a2[1] : a2[0], send = h3 ? a2[0] : a2[1]; a1 = keep + __shfl_xor(send, 8); }
        a1 += __shfl_xor(a1, 4); a1 += __shfl_xor(a1, 2); a1 += __shfl_xor(a1, 1);
        if ((lane & 7) == 0) gbuf[(size_t)(m0 + rr) * 8 + (lane >> 3)] = rs * a1 + bgate;
        if (lane == 0) rs1[m0 + rr] = rs;
    }
}
__device__ __forceinline__ void p1_wout(Frame& F, const Args& a, int cw) {
    LAS float* scr = (LAS float*)(F.lds + F.wave * 8448);
    const int it = cw * 8 + F.wave;
    if (it < 16 * 32) { const int kb = it / 32, nb = it % 32; p0_transpose_item<true>(a.in[5], 1024, 32 * nb, nullptr, (float)(1 << FP8_W_SHIFT), (void*)(F.ws + WS_WOUT), 1024, 32 * nb, 64 * kb, scr, F.lane); }
    __syncthreads();
}
__device__ __forceinline__ void p0_prep(Frame& F, const Args& a) {
    const float* x = a.in[0]; const float* norm_mix = a.in[1]; const float* w_in = a.in[2]; const float* b_in = a.in[3]; const float* w_out = a.in[5];
    const float* norm_ffn = a.in[6]; const float* w_group = a.in[7]; const float* b_group = a.in[8]; const float* w_expert = a.in[9]; const float* b_expert = a.in[10];
    const float* w_gate = a.in[11]; const float* w_up = a.in[12]; const float* w_down = a.in[13];
    bf16_t* WinT = (bf16_t*)(F.ws + WS_WIN); bf16_t* WoutT = (bf16_t*)(F.ws + WS_WOUT); bf16_t* WrT = (bf16_t*)(F.ws + WS_WR);
    float* binp = (float*)(F.ws + WS_WR + 128 * 1024); float* brt = (float*)(F.ws + WS_WR + 160 * 1024);
    bf16_t* W1T = (bf16_t*)(F.ws + WS_W1); bf16_t* W2T = (bf16_t*)(F.ws + WS_W2);
    bf16_t* xb = (bf16_t*)(F.ws + WS_R2); float* rs1 = (float*)(F.ws + WS_RS1); float* gbuf = (float*)(F.ws + WS_GATES);
    LAS float* scr = (LAS float*)(F.lds + F.wave * 8448);
    LAS float* wgs = (LAS float*)(F.lds + 67584);
    const int gw = F.vcu * 8 + F.wave, NGW = F.G * 8, gt = F.vcu * 512 + F.tid, NGT = F.G * 512;
    const float QS = 0.08838834764831845f;
    const int lane = F.lane;
    constexpr int RW = 2;
    const int step = NGW * RW;
    f32x4 va[RW][4], vb[RW][4];
#define P0_LOAD(dst, m) do { _Pragma("unroll") for (int rr = 0; rr < RW; ++rr) _Pragma("unroll") for (int j = 0; j < 4; ++j) dst[rr][j] = __builtin_nontemporal_load((const f32x4*)(x + (size_t)((m) + rr) * D) + 64 * j + lane); asm volatile("" ::: "memory"); } while (0)
    P0_LOAD(va, gw * RW);
    const float bgate = b_in[2048 + (lane >> 3)];
    float wv_[16], nm_[16]; const int gfi = F.tid & 7, kf0 = F.tid >> 3;
#pragma unroll
    for (int i = 0; i < 16; ++i) { wv_[i] = w_in[(size_t)(kf0 + 64 * i) * NPROJ_IN + 2048 + gfi]; nm_[i] = norm_mix[kf0 + 64 * i]; }
    asm volatile("" ::: "memory");
    for (int i = gt; i < NPROJ; i += NGT) { const int col = i < 2048 ? i : i + 8; binp[i] = b_in[col] * (i < 512 ? QS : 1.0f); }
    for (int i = gt; i < 48; i += NGT) brt[i] = i < 4 ? b_group[i] : (i < 36 ? b_expert[i - 4] : 0.f);
    for (int i = gt; i < 48 * 1024; i += NGT) { const int j = i >> 10, k = i & 1023; float v = 0.f; if (j < 4) v = w_group[k * 4 + j]; else if (j < 36) v = w_expert[k * 32 + (j - 4)];
        WrT[i] = (bf16_t)(cvtpk(v * norm_ffn[k], 0.f) & 0xffffu); }
    constexpr int I_IN = 16 * 112;
    for (int it = gw; it < I_IN; it += NGW) { const int kb = it / 112, nb = it % 112, n0 = 32 * nb;
        p0_transpose_item<false>(w_in, NPROJ_IN, n0 < 2048 ? n0 : n0 + 8, norm_mix, n0 < 512 ? QS : 1.0f, WinT, 1024, n0, 64 * kb, scr, F.lane); }
    asm volatile("" ::: "memory");
#pragma unroll
    for (int i = 0; i < 16; ++i) wgs[gfi * 1024 + kf0 + 64 * i] = wv_[i] * nm_[i];
    __syncthreads();
    for (int m0 = gw * RW; m0 < NTOK; m0 += 2 * step) {
        const int m1 = m0 + step, m2 = m0 + 2 * step;
        P0_LOAD(vb, m1 < NTOK ? m1 : m0);
        p0_rows<RW>(va, m0, wgs, xb, gbuf, rs1, bgate, lane);
        P0_LOAD(va, m2 < NTOK ? m2 : m0);
        if (m1 < NTOK) p0_rows<RW>(vb, m1, wgs, xb, gbuf, rs1, bgate, lane);
    }
#undef P0_LOAD
}
constexpr int NITEMS_GU = NE * 512, NITEMS_DN = NE * 256;
__device__ __forceinline__ void expert_item(Frame& F, const Args& a, bool down, int it) {
    const float* norm_ffn = a.in[6]; const float* w_gate = a.in[11]; const float* w_up = a.in[12]; const float* w_down = a.in[13];
    unsigned char* W1T = (unsigned char*)(F.ws + WS_W1); unsigned char* W2T = (unsigned char*)(F.ws + WS_W2);
    LAS float* scr = (LAS float*)(F.lds + F.wave * 8448);
    const float ws = (float)(1 << FP8_W_SHIFT);
    if (!down) { const int e = it >> 9, r = it & 511, up = r >> 8, rr = r & 255, kb = rr / 16, nb = rr % 16, f0 = 32 * nb;
        p0_transpose_item<true>((up ? w_up : w_gate) + (size_t)e * 1024 * 512, 512, f0, norm_ffn, ws, W1T + (size_t)e * 1024 * 1024, 1024, 256 * (f0 >> 7) + (f0 & 127) + 128 * up, 64 * kb, scr, F.lane); }
    else { const int e = it >> 8, rr = it & 255, kb = rr / 32, nb = rr % 32; p0_transpose_item<true>(w_down + (size_t)e * 512 * 1024, 1024, 32 * nb, nullptr, ws, W2T + (size_t)e * 1024 * 512, 512, 32 * nb, 64 * kb, scr, F.lane); }
}
constexpr int QB = 16;
__device__ __forceinline__ void expert_queue(Frame& F, const Args& a, bool down, int max_deq = 1 << 30, int reserve = 0) {
    volatile LAS unsigned* qw = (volatile LAS unsigned*)(F.lds + LDSCTL_OFF + 64);
    const int nitems = down ? NITEMS_DN : NITEMS_GU;
    for (int dq = 0; dq < max_deq; ++dq) {
        __syncthreads();
        if (F.tid == 0) qw[0] = __hip_atomic_fetch_add(F.ctl + (down ? CW_QUEUE2 : CW_QUEUE), (unsigned)QB, __ATOMIC_RELAXED, __HIP_MEMORY_SCOPE_AGENT);
        __syncthreads();
        const int base = (int)qw[0];
        if (base >= nitems) break;
        if (base >= nitems - reserve) max_deq = 0;
        for (int i = 0; i < QB / 8; ++i) { const int it = base + F.wave * (QB / 8) + i; if (it < nitems) expert_item(F, a, down, it); }
    }
    __syncthreads();
}

constexpr int M2_KS = 0, M2_QS = 34816, M2_WVS = 69632, M2_PS = 91136, M2_CS = 109568, M2_MCH = 135680, M2_END = 136704;
constexpr int M2_KSZ = 17408, M2_WSZ = 7168, M2_PSZ = 9216, M2_CSZ = 13056;
constexpr int ML_QSTR = 272, ML_WSTR = 112, ML_PSTR = 144;
__device__ __forceinline__ bf16x8 tr_frag(const LAS unsigned char* base, int stride) {
    const s16x4 lo = __builtin_amdgcn_ds_read_tr16_b64_v4i16((LAS s16x4*)(base));
    const s16x4 hi = __builtin_amdgcn_ds_read_tr16_b64_v4i16((LAS s16x4*)(base + 4 * stride));
    return (bf16x8){lo[0], lo[1], lo[2], lo[3], hi[0], hi[1], hi[2], hi[3]};
}
__device__ __forceinline__ u32x4 scale_f8(u32x2 v, float w) {
    const f32x2 a = __builtin_amdgcn_cvt_pk_f32_fp8((int)v.x, false), b = __builtin_amdgcn_cvt_pk_f32_fp8((int)v.x, true), c = __builtin_amdgcn_cvt_pk_f32_fp8((int)v.y, false), d = __builtin_amdgcn_cvt_pk_f32_fp8((int)v.y, true);
    u32x4 o; o.x = cvtpk(a.x * w, a.y * w); o.y = cvtpk(b.x * w, b.y * w); o.z = cvtpk(c.x * w, c.y * w); o.w = cvtpk(d.x * w, d.y * w); return o;
}
struct MlCtx {
    LAS unsigned char* L; const LAS float* mch; const float* gsc;
    const bf16_t* projb; unsigned char* ymcb; unsigned ok, ov, oq, oo, oy;
    int tid, lane, wid, r, q, qrow0, qseg, vrow, vseg, srow, lt, et, dt, lrow, trrow, trcol;
};
struct MlRegs {
    u32x4 sk0[2], sk1[2], sq0[2], sq1[2]; u32x2 sv[2]; float ss[2];
    float pm[3], bc[3]; unsigned og[2];
    f32x4 accC[3], xe, xd;
};
constexpr size_t ML_CSTEP = (size_t)CH * NPROJ;
template <bool ST, bool FG, bool OUT, int K3, int K2>
__device__ __forceinline__ void ml_iter(const MlCtx& C, MlRegs& R, const int k) {
    LAS unsigned char* L = C.L; const int r = C.r, q = C.q, lt = C.lt, et = C.et, dt = C.dt, lrow = C.lrow, trrow = C.trrow, trcol = C.trcol;
    constexpr int S1 = (K3 + 1) % 3, S2 = (K3 + 2) % 3;
    const u32x4 rk0 = R.sk0[K2], rk1 = R.sk1[K2], rq0 = R.sq0[K2], rq1 = R.sq1[K2]; const u32x2 rv = R.sv[K2]; const float sst = R.ss[K2];
    const float pm_o = R.pm[S1], bc_o = R.bc[S1]; const unsigned og_o = R.og[K2];
    const float pm_f = R.pm[S2];
    const f32x4 xe_o = R.xe, xd_o = R.xd;
    {
        const int k2 = (k + 2 < NCH) ? k + 2 : NCH - 1, k1 = (k + 1 < NCH) ? k + 1 : NCH - 1, k0 = (k < NCH) ? k : NCH - 1;
        const size_t a2 = (size_t)k2 * ML_CSTEP, a1 = (size_t)k1 * ML_CSTEP;
        const bf16_t* b2 = C.projb + a2; const bf16_t* b1 = C.projb + a1;
        R.sk0[K2] = *(const u32x4*)(b2 + C.ok); R.sk1[K2] = *(const u32x4*)(b2 + 32 * NPROJ + C.ok); R.sq0[K2] = *(const u32x4*)(b2 + C.ok - 512); R.sq1[K2] = *(const u32x4*)(b2 + 32 * NPROJ + C.ok - 512); R.sv[K2] = *(const u32x2*)((const char*)b2 + C.ov); R.ss[K2] = C.gsc[k2 * 192 + C.srow];
        R.pm[S1] = C.gsc[k1 * 192 + 64 + lrow]; R.bc[S1] = C.gsc[k1 * 192 + 128 + lrow];
        { const int km = (k >= 1) ? ((k - 1 < NCH) ? k - 1 : NCH - 1) : 0; R.og[K2 ^ 1] = *(const unsigned*)((const char*)(C.projb + (size_t)km * ML_CSTEP) + C.oo); }
    }
    if constexpr (ST) {
        const float M63s = C.mch[2 * k + 1]; const float w = __expf(sst - M63s);
        LAS unsigned char* ks = L + M2_KS + K2 * M2_KSZ; LAS unsigned char* wv = L + M2_WVS + K3 * M2_WSZ;
        *(LAS u32x4*)(ks + C.qrow0 * ML_QSTR + C.qseg * 16) = rk0; *(LAS u32x4*)(ks + (C.qrow0 + 32) * ML_QSTR + C.qseg * 16) = rk1;
        { LAS unsigned char* qs = L + M2_QS + K2 * M2_KSZ; *(LAS u32x4*)(qs + C.qrow0 * ML_QSTR + C.qseg * 16) = rq0; *(LAS u32x4*)(qs + (C.qrow0 + 32) * ML_QSTR + C.qseg * 16) = rq1; }
        if (C.tid < 256) *(LAS u32x4*)(wv + C.vrow * ML_WSTR + C.vseg * 16) = scale_f8(rv, w * (1.0f / (float)(1 << FP8_P_SHIFT)));
        if (C.wid == 4) *(LAS u32x4*)(wv + C.lane * ML_WSTR + 64) = (u32x4){cvtpk(w, 0.f), 0u, 0u, 0u};
    }
    f32x4 ie = (f32x4){0.f, 0.f, 0.f, 0.f}, id = ie;
    if constexpr (OUT) {
        const LAS unsigned char* ps = L + M2_PS + K2 * M2_PSZ; const LAS unsigned char* wv = L + M2_WVS + S1 * M2_WSZ;
        bf16x8 bp[2], av[2], ad[2];
#pragma unroll
        for (int js = 0; js < 2; ++js) {
            bp[js] = *(const LAS bf16x8*)(ps + lrow * ML_PSTR + js * 64 + q * 16);
            av[js] = tr_frag(wv + (32 * js + 8 * q + trrow) * ML_WSTR + (16 * et + trcol) * 2, ML_WSTR);
            ad[js] = tr_frag(wv + (32 * js + 8 * q + trrow) * ML_WSTR + (32 + trcol) * 2, ML_WSTR);
        }
#pragma unroll
        for (int js = 0; js < 2; ++js) { ie = __builtin_amdgcn_mfma_f32_16x16x32_bf16(av[js], bp[js], ie, 0, 0, 0); id = __builtin_amdgcn_mfma_f32_16x16x32_bf16(ad[js], bp[js], id, 0, 0, 0); }
    }
    if constexpr (FG) {
        const int j = k - 1;
        const LAS unsigned char* ksF = L + M2_KS + (K2 ^ 1) * M2_KSZ; const LAS unsigned char* wvF = L + M2_WVS + S2 * M2_WSZ; const LAS unsigned char* cs = L + M2_CS + (K2 ^ 1) * M2_CSZ;
        LAS unsigned char* ps = L + M2_PS + (K2 ^ 1) * M2_PSZ; LAS unsigned char* csn = L + M2_CS + K2 * M2_CSZ;
        const float mp = C.mch[2 * j], M63 = C.mch[2 * j + 1];
        const float fl = __expf(M63 - fmaxf(mp, pm_f)), decay = __expf(mp - M63);
        f32x4 sacc[2], xe = (f32x4){0.f, 0.f, 0.f, 0.f}, xd = xe;
        bf16x8 qf[4];
        { const LAS unsigned char* qs = L + M2_QS + (K2 ^ 1) * M2_KSZ;
#pragma unroll
          for (int ds = 0; ds < 4; ++ds) qf[ds] = *(const LAS bf16x8*)(qs + lrow * ML_QSTR + ds * 64 + q * 16); }
#pragma unroll
        for (int ti = 0; ti < 2; ++ti) {
            const int jt = et + 2 * ti, jtc = jt <= lt ? jt : lt;
            bf16x8 kf[4], ax[4];
#pragma unroll
            for (int ds = 0; ds < 4; ++ds) { kf[ds] = *(const LAS bf16x8*)(ksF + (16 * jtc + r) * ML_QSTR + ds * 64 + q * 16);
                ax[ds] = *(const LAS bf16x8*)(cs + ((ti ? 32 : 16 * et) + r) * ML_QSTR + ds * 64 + q * 16); }
            sacc[ti] = (f32x4){0.f, 0.f, 0.f, 0.f};
#pragma unroll
            for (int ds = 0; ds < 4; ++ds) { const bf16x8 bq = qf[ds];
                sacc[ti] = __builtin_amdgcn_mfma_f32_16x16x32_bf16(kf[ds], bq, sacc[ti], 0, 0, 0);
                if (ti == 0) xe = __builtin_amdgcn_mfma_f32_16x16x32_bf16(ax[ds], bq, xe, 0, 0, 0); else xd = __builtin_amdgcn_mfma_f32_16x16x32_bf16(ax[ds], bq, xd, 0, 0, 0); }
            __builtin_amdgcn_sched_barrier(0);
        }
        R.xe = xe; R.xd = xd;
        {
            bf16x8 ga[2], gb[2][3];
#pragma unroll
            for (int js = 0; js < 2; ++js) { const int jrow = 32 * js + 8 * q + trrow;
                ga[js] = tr_frag(ksF + jrow * ML_QSTR + (16 * dt + trcol) * 2, ML_QSTR);
#pragma unroll
                for (int e3 = 0; e3 < 3; ++e3) gb[js][e3] = tr_frag(wvF + jrow * ML_WSTR + (16 * e3 + trcol) * 2, ML_WSTR); }
#pragma unroll
            for (int i = 0; i < 3; ++i) R.accC[i] = R.accC[i] * decay;
#pragma unroll
            for (int js = 0; js < 2; ++js)
#pragma unroll
                for (int e3 = 0; e3 < 3; ++e3) R.accC[e3] = __builtin_amdgcn_mfma_f32_16x16x32_bf16(ga[js], gb[js][e3], R.accC[e3], 0, 0, 0);
        }
#pragma unroll
        for (int ti = 0; ti < 2; ++ti) {
            const int jt = et + 2 * ti;
            if (jt <= lt) { const int j0 = 16 * jt + 4 * q; float p[4];
#pragma unroll
                for (int i = 0; i < 4; ++i) p[i] = (j0 + i <= lrow) ? sacc[ti][i] * fl : 0.f;
                *(LAS u32x2*)(ps + lrow * ML_PSTR + j0 * 2) = (u32x2){cvtpk(p[0], p[1]), cvtpk(p[2], p[3])}; }
        }
#pragma unroll
        for (int e3 = 0; e3 < 3; ++e3) *(LAS u32x2*)(csn + (16 * e3 + r) * ML_QSTR + (16 * dt + 4 * q) * 2) = (u32x2){cvtpk(R.accC[e3][0], R.accC[e3][1]), cvtpk(R.accC[e3][2], R.accC[e3][3])};
    }
    if constexpr (OUT) {
        const int j = k - 2;
        const float mp = C.mch[2 * j]; const float Ml = fmaxf(mp, pm_o); const float wl = __expf(mp - Ml), el = __expf(-bc_o - Ml);
        float den = id[0] + wl * xd_o[0]; den = __shfl(den, r);
        const float nrm = __builtin_amdgcn_rcpf(fmaxf(fabsf(den), el));
        const f32x2 oa = __builtin_amdgcn_cvt_pk_f32_fp8((int)og_o, false), ob = __builtin_amdgcn_cvt_pk_f32_fp8((int)og_o, true); const float osc = 1.0f / (float)(1 << FP8_P_SHIFT);
        const float o0 = oa.x * osc, o1 = oa.y * osc, o2 = ob.x * osc, o3 = ob.y * osc;
        const float y0 = (ie[0] + wl * xe_o[0]) * nrm * __builtin_amdgcn_rcpf(1.0f + __expf(-o0)), y1 = (ie[1] + wl * xe_o[1]) * nrm * __builtin_amdgcn_rcpf(1.0f + __expf(-o1));
        const float y2 = (ie[2] + wl * xe_o[2]) * nrm * __builtin_amdgcn_rcpf(1.0f + __expf(-o2)), y3 = (ie[3] + wl * xe_o[3]) * nrm * __builtin_amdgcn_rcpf(1.0f + __expf(-o3));
        { const float ysc = (float)(1 << FP8_YM_SHIFT);
          const float z0 = __builtin_amdgcn_fmed3f(y0 * ysc, -448.f, 448.f), z1 = __builtin_amdgcn_fmed3f(y1 * ysc, -448.f, 448.f), z2 = __builtin_amdgcn_fmed3f(y2 * ysc, -448.f, 448.f), z3 = __builtin_amdgcn_fmed3f(y3 * ysc, -448.f, 448.f);
          unsigned w8 = (unsigned)__builtin_amdgcn_cvt_pk_fp8_f32(z0, z1, 0, false); w8 = (unsigned)__builtin_amdgcn_cvt_pk_fp8_f32(z2, z3, (int)w8, true);
          *(unsigned*)(C.ymcb + (size_t)j * CH * D + C.oy) = w8; }
    }
    __syncthreads();
}
__device__ __forceinline__ void ml_gates(Frame& F, int unit, bool to_global) {
    const float* gbuf = (const float*)(F.ws + WS_GATES);
    float* gsc = (float*)(F.ws + WS_GSC) + (size_t)unit * (NCH * 192);
    const int b = unit >> 4, h = (unit >> 2) & 3;
    const int tid = F.tid, lane = F.lane, wid = F.wave;
    const size_t tok0 = (size_t)b * SEQ;
    LAS float* mch = (LAS float*)(F.lds + M2_MCH);
    LAS float* gtv = mch + 128;
    {
        float bcv[8], sjv[8], pmv[8];
#pragma unroll
        for (int i = 0; i < 8; ++i) { const float* pg = gbuf + (tok0 + (size_t)(wid + 8 * i) * CH + lane) * 8 + h; const float ig = pg[0], fg = pg[4];
            bcv[i] = fminf(fg, 0.f) - log1pf(__expf(-fabsf(fg))); sjv[i] = ig; }
#pragma unroll
        for (int o = 1; o < 64; o <<= 1) {
#pragma unroll
            for (int i = 0; i < 8; ++i) { const float t = __shfl_up(bcv[i], o); bcv[i] = (lane >= o) ? bcv[i] + t : bcv[i]; } }
#pragma unroll
        for (int i = 0; i < 8; ++i) { sjv[i] = sjv[i] - bcv[i]; pmv[i] = sjv[i]; }
#pragma unroll
        for (int o = 1; o < 64; o <<= 1) {
#pragma unroll
            for (int i = 0; i < 8; ++i) { const float t = __shfl_up(pmv[i], o); pmv[i] = (lane >= o) ? fmaxf(pmv[i], t) : pmv[i]; } }
#pragma unroll
        for (int i = 0; i < 8; ++i) { const int c = wid + 8 * i;
            gsc[c * 192 + lane] = sjv[i]; gsc[c * 192 + 64 + lane] = pmv[i]; gsc[c * 192 + 128 + lane] = bcv[i];
            if (lane == 63) { gtv[c] = bcv[i]; gtv[64 + c] = pmv[i]; } }
    }
    __syncthreads();
    if (wid == 0) {
        const float g = gtv[lane], p = gtv[64 + lane];
        float a = g, bq = p + g;
#pragma unroll
        for (int o = 1; o < 64; o <<= 1) { const float ap = __shfl_up(a, o), bp = __shfl_up(bq, o); if (lane >= o) { bq = fmaxf(bp + a, bq); a = ap + a; } }
        const float mnext = fmaxf(a, bq);
        float m = __shfl_up(mnext, 1); if (lane == 0) m = 0.f;
        mch[2 * lane] = m; mch[2 * lane + 1] = fmaxf(m, p);
    }
    __syncthreads();
    if (to_global && tid < 128) ((float*)(F.ws + WS_MCHG))[unit * 128 + tid] = mch[tid];
}
__device__ __forceinline__ void mlstm_unit(Frame& F, int unit, int gates) {
    const bf16_t* proj = (const bf16_t*)(F.ws + WS_R1); const float* gbuf = (const float*)(F.ws + WS_GATES); unsigned char* ymc = (unsigned char*)(F.ws + WS_YMC);
    float* gsc = (float*)(F.ws + WS_GSC) + (size_t)unit * (NCH * 192);
    LAS unsigned char* L = F.lds;
    const int b = unit >> 4, h = (unit >> 2) & 3, es = unit & 3;
    const int tid = F.tid, lane = F.lane, wid = F.wave, r = lane & 15, q = lane >> 4;
    const size_t tok0 = (size_t)b * SEQ;
    LAS float* mch = (LAS float*)(L + M2_MCH);
    LAS float* gtv = mch + 128;
    for (int i = tid; i < M2_MCH / 16; i += 512) *(LAS u32x4*)(L + i * 16) = (u32x4){0u, 0u, 0u, 0u};
    if (gates == 0) ml_gates(F, unit, false);
    float mchv = 0.f; if (gates == 2 && tid < 128) mchv = ((const float*)(F.ws + WS_MCHG))[unit * 128 + tid];
    MlCtx C; MlRegs R;
    C.L = L; C.mch = mch; C.gsc = gsc; C.tid = tid; C.lane = lane; C.wid = wid; C.r = r; C.q = q;
    C.qrow0 = tid >> 4; C.qseg = tid & 15; C.vrow = (tid & 255) >> 2; C.vseg = tid & 3; C.srow = (wid == 4) ? lane : C.vrow;
    C.lt = wid & 3; C.et = wid >> 2; C.dt = wid; C.lrow = 16 * C.lt + r; C.trrow = (lane & 15) >> 2; C.trcol = (lane & 3) * 4;
    C.projb = proj + tok0 * NPROJ; C.ymcb = ymc + tok0 * D;
    C.ok = (unsigned)(C.qrow0 * NPROJ + 512 + h * DH + C.qseg * 8);
    C.ov = (unsigned)(C.vrow * NPROJ * 2 + PROJ_F8_BYTE(1024 + h * DH + es * 32 + C.vseg * 8));
    C.oo = (unsigned)(C.lrow * NPROJ * 2 + PROJ_F8_BYTE(1536 + h * DH + es * 32 + 16 * C.et + 4 * q));
    C.oy = (unsigned)(C.lrow * D + h * DH + es * 32 + 16 * C.et + 4 * q);
    R.sk0[0] = *(const u32x4*)(C.projb + C.ok); R.sk1[0] = *(const u32x4*)(C.projb + 32 * NPROJ + C.ok); R.sq0[0] = *(const u32x4*)(C.projb + C.ok - 512); R.sq1[0] = *(const u32x4*)(C.projb + 32 * NPROJ + C.ok - 512); R.sv[0] = *(const u32x2*)((const char*)C.projb + C.ov);
    R.sk0[1] = *(const u32x4*)(C.projb + ML_CSTEP + C.ok); R.sk1[1] = *(const u32x4*)(C.projb + ML_CSTEP + 32 * NPROJ + C.ok); R.sq0[1] = *(const u32x4*)(C.projb + ML_CSTEP + C.ok - 512); R.sq1[1] = *(const u32x4*)(C.projb + ML_CSTEP + 32 * NPROJ + C.ok - 512); R.sv[1] = *(const u32x2*)((const char*)(C.projb + ML_CSTEP) + C.ov);
#pragma unroll
    for (int sl = 0; sl < 3; ++sl) { R.pm[sl] = 0.f; R.bc[sl] = 0.f; }
    R.og[0] = 0u; R.og[1] = 0u;
#pragma unroll
    for (int i = 0; i < 3; ++i) R.accC[i] = (f32x4){0.f, 0.f, 0.f, 0.f};
    R.xe = (f32x4){0.f, 0.f, 0.f, 0.f}; R.xd = R.xe;
    if (gates == 2 && tid < 128) mch[tid] = mchv;
    __syncthreads();
    R.ss[0] = gsc[C.srow]; R.ss[1] = gsc[192 + C.srow]; R.pm[0] = gsc[64 + C.lrow]; R.bc[0] = gsc[128 + C.lrow];
    ml_iter<true, false, false, 0, 0>(C, R, 0);
    ml_iter<true, true, false, 1, 1>(C, R, 1);
    ml_iter<true, true, true, 2, 0>(C, R, 2);
    ml_iter<true, true, true, 0, 1>(C, R, 3);
    for (int k = 4; k < NCH; k += 6) {
        ml_iter<true, true, true, 1, 0>(C, R, k);     ml_iter<true, true, true, 2, 1>(C, R, k + 1); ml_iter<true, true, true, 0, 0>(C, R, k + 2);
        ml_iter<true, true, true, 1, 1>(C, R, k + 3); ml_iter<true, true, true, 2, 0>(C, R, k + 4); ml_iter<true, true, true, 0, 1>(C, R, k + 5);
    }
    ml_iter<false, true, true, 1, 0>(C, R, NCH);
    ml_iter<false, false, true, 2, 1>(C, R, NCH + 1);
}
__device__ __forceinline__ void conv_part(Frame& F, const float* conv_w, int part) {
    const unsigned char* projc = (const unsigned char*)(F.ws + WS_R1); unsigned char* ymc = (unsigned char*)(F.ws + WS_YMC);
    const int cg = F.tid & 63, sub = F.tid >> 6; const int T0 = part * 256 + sub * 32;
    constexpr size_t RP = (size_t)NPROJ * 2;
    float w0[8], w1[8], w2[8], u1[8], u2[8];
#pragma unroll
    for (int i = 0; i < 8; ++i) { const float ysc = (float)(1 << FP8_YM_SHIFT) / (float)(1 << (3 * FP8_P_SHIFT));
        w0[i] = conv_w[8 * cg + i] * ysc; w1[i] = conv_w[512 + 8 * cg + i] * ysc; w2[i] = conv_w[1024 + 8 * cg + i] * ysc; u1[i] = 0.f; u2[i] = 0.f; }
#define CVCL(v) __builtin_amdgcn_fmed3f((v), -448.f, 448.f)
#define CVU8(dst, v) do { const f32x2 a_ = __builtin_amdgcn_cvt_pk_f32_fp8((int)(v).x, false), b_ = __builtin_amdgcn_cvt_pk_f32_fp8((int)(v).x, true), c_ = __builtin_amdgcn_cvt_pk_f32_fp8((int)(v).y, false), d_ = __builtin_amdgcn_cvt_pk_f32_fp8((int)(v).y, true); \
        dst[0] = a_.x; dst[1] = a_.y; dst[2] = b_.x; dst[3] = b_.y; dst[4] = c_.x; dst[5] = c_.y; dst[6] = d_.x; dst[7] = d_.y; } while (0)
    if ((T0 & (SEQ - 1)) != 0) {
        const unsigned char* p1 = projc + (size_t)(T0 - 1) * RP + PROJ_F8_BYTE(2560 + 8 * cg); const unsigned char* p2 = projc + (size_t)(T0 - 2) * RP + PROJ_F8_BYTE(2560 + 8 * cg);
        const u32x2 c1 = *(const u32x2*)p1, x1 = *(const u32x2*)(p1 + 512), c2 = *(const u32x2*)p2, x2 = *(const u32x2*)(p2 + 512);
        float fc1[8], fx1[8], fc2[8], fx2[8]; CVU8(fc1, c1); CVU8(fx1, x1); CVU8(fc2, c2); CVU8(fx2, x2);
#pragma unroll
        for (int i = 0; i < 8; ++i) { u1[i] = fc1[i] * fx1[i]; u2[i] = fc2[i] * fx2[i]; }
    }
    u32x2 la[4][3], lb[4][3];
#define CV_LOAD(dst, t0) do { _Pragma("unroll") for (int i_ = 0; i_ < 4; ++i_) { const unsigned char* pp = projc + (size_t)(T0 + (t0) + i_) * RP + PROJ_F8_BYTE(2048 + 8 * cg); \
        dst[i_][0] = *(const u32x2*)pp; dst[i_][1] = *(const u32x2*)(pp + 512); dst[i_][2] = *(const u32x2*)(pp + 1024); } asm volatile("" ::: "memory"); } while (0)
#define CV_STEPS(src, t0) do { _Pragma("unroll") for (int i_ = 0; i_ < 4; ++i_) { float fb[8], fc[8], fx[8], y[8]; CVU8(fb, src[i_][0]); CVU8(fc, src[i_][1]); CVU8(fx, src[i_][2]); \
        _Pragma("unroll") for (int i = 0; i < 8; ++i) { const float ua = fc[i] * fx[i]; \
            y[i] = fb[i] * (w0[i] * u2[i] + w1[i] * u1[i] + w2[i] * ua); u2[i] = u1[i]; u1[i] = ua; } \
        { u32x2 w8; \
          w8.x = (unsigned)__builtin_amdgcn_cvt_pk_fp8_f32(CVCL(y[0]), CVCL(y[1]), 0, false); w8.x = (unsigned)__builtin_amdgcn_cvt_pk_fp8_f32(CVCL(y[2]), CVCL(y[3]), (int)w8.x, true); \
          w8.y = (unsigned)__builtin_amdgcn_cvt_pk_fp8_f32(CVCL(y[4]), CVCL(y[5]), 0, false); w8.y = (unsigned)__builtin_amdgcn_cvt_pk_fp8_f32(CVCL(y[6]), CVCL(y[7]), (int)w8.y, true); \
          *(u32x2*)(ymc + (size_t)(T0 + (t0) + i_) * D + 512 + 8 * cg) = w8; } } asm volatile("" ::: "memory"); } while (0)
    CV_LOAD(la, 0);
    for (int t0 = 0; t0 < 32; t0 += 8) {
        CV_LOAD(lb, t0 + 4); CV_STEPS(la, t0);
        CV_LOAD(la, t0 + 8 < 32 ? t0 + 8 : t0); CV_STEPS(lb, t0 + 4);
    }
#undef CV_LOAD
#undef CV_STEPS
#undef CVCL
#undef CVU8
}

constexpr int RT_WSTR = 2064, RT_SCR = 99328, RT_LCNT = 124928, RT_GBASE = 125184, RT_BIAS = 125440;
__device__ __forceinline__ void p4_router(Frame& F) {
    const bf16_t* WrT = (const bf16_t*)(F.ws + WS_WR); const float* brt = (const float*)(F.ws + WS_WR + 160 * 1024);
    const bf16_t* x1b = (const bf16_t*)(F.ws + WS_X1B); unsigned char* x1q = (unsigned char*)(F.ws + WS_X1Q); int* list = (int*)(F.ws + WS_LIST); float* lrs = (float*)(F.ws + WS_LRS); unsigned* tokinfo = (unsigned*)(F.ws + WS_TOKINFO);
    unsigned* gcnt = F.ctl + CW_CNT;
    LAS unsigned char* L = F.lds; const int tid = F.tid, lane = F.lane, wid = F.wave, r = lane & 15, q = lane >> 4;
    LAS int* lcnt = (LAS int*)(L + RT_LCNT); LAS int* gbase = (LAS int*)(L + RT_GBASE); LAS float* lbias = (LAS float*)(L + RT_BIAS);
    LAS float* scr = (LAS float*)(L + RT_SCR + wid * 3072);
    {
        u32x4 wtmp[12];
#pragma unroll
        for (int i = 0; i < 12; ++i) wtmp[i] = *(const u32x4*)(WrT + (size_t)(tid + 512 * i) * 8);
        asm volatile("" ::: "memory");
#pragma unroll
        for (int i = 0; i < 12; ++i) { const int p = tid + 512 * i, row = p >> 7, seg = p & 127; *(LAS u32x4*)(L + row * RT_WSTR + seg * 16) = wtmp[i]; }
    }
    if (tid < 48) lbias[tid] = brt[tid];
    for (int tile = F.vcu; tile < NTOK / 128; tile += F.G) {
        if (tid < 32) lcnt[tid] = 0;
        __syncthreads();
        const int tokb = tile * 128 + wid * 16;
        f32x4 acc[3]; acc[0] = (f32x4){0.f, 0.f, 0.f, 0.f}; acc[1] = acc[0]; acc[2] = acc[0];
        float ss = 0.f;
        const bf16_t* brow = x1b + (size_t)(tokb + r) * D + 8 * q; unsigned char* qrow = x1q + (size_t)(tokb + r) * D + 8 * q;
        u32x4 pa[8], pb[8];
#define P4_LOAD(dst, kb) do { _Pragma("unroll") for (int i_ = 0; i_ < 8; ++i_) dst[i_] = *(const u32x4*)(brow + 32 * ((kb) * 8 + i_)); asm volatile("" ::: "memory"); } while (0)
#define P4_STEPS(src, kb) do { _Pragma("unroll") for (int i_ = 0; i_ < 8; ++i_) { const int ks = (kb) * 8 + i_; const u32x4 pk = src[i_]; u32x2 q8; \
            _Pragma("unroll") for (int i = 0; i < 4; ++i) { const float lo = bflo(pk[i]), hi = bfhi(pk[i]); ss += lo * lo + hi * hi; \
                if (i == 0) q8.x = (unsigned)__builtin_amdgcn_cvt_pk_fp8_f32(lo, hi, 0, false); else if (i == 1) q8.x = (unsigned)__builtin_amdgcn_cvt_pk_fp8_f32(lo, hi, (int)q8.x, true); \
                else if (i == 2) q8.y = (unsigned)__builtin_amdgcn_cvt_pk_fp8_f32(lo, hi, 0, false); else q8.y = (unsigned)__builtin_amdgcn_cvt_pk_fp8_f32(lo, hi, (int)q8.y, true); } \
            *(u32x2*)(qrow + 32 * ks) = q8; \
            const bf16x8 af = __builtin_bit_cast(bf16x8, pk); \
            _Pragma("unroll") for (int nt = 0; nt < 3; ++nt) { const bf16x8 bfr = *(const LAS bf16x8*)(L + (16 * nt + r) * RT_WSTR + ks * 64 + q * 16); acc[nt] = __builtin_amdgcn_mfma_f32_16x16x32_bf16(af, bfr, acc[nt], 0, 0, 0); } } } while (0)
        P4_LOAD(pa, 0); P4_LOAD(pb, 1);
        P4_STEPS(pa, 0); asm volatile("" ::: "memory");
        P4_LOAD(pa, 2);
        P4_STEPS(pb, 1); asm volatile("" ::: "memory");
        P4_LOAD(pb, 3);
        P4_STEPS(pa, 2); asm volatile("" ::: "memory");
        P4_STEPS(pb, 3);
#undef P4_LOAD
#undef P4_STEPS
        ss += __shfl_xor(ss, 16); ss += __shfl_xor(ss, 32);
        const float rs = 1.0f / sqrtf(ss * (1.0f / D) + RMS_EPS);
#pragma unroll
        for (int nt = 0; nt < 3; ++nt)
#pragma unroll
            for (int i = 0; i < 4; ++i) scr[(4 * q + i) * 48 + 16 * nt + r] = acc[nt][i];
        LDS_WAIT(); asm volatile("" ::: "memory");
        int e0 = 0, e1 = 0, p0 = 0, p1 = 0; float w0 = 0.f, w1 = 0.f;
        if (lane < 16) {
            const LAS float* lg = scr + lane * 48;
            float gl[4];
#pragma unroll
            for (int i = 0; i < 4; ++i) gl[i] = rs * lg[i] + lbias[i];
            int g = 0; float gm = gl[0];
#pragma unroll
            for (int i = 1; i < 4; ++i) if (gl[i] > gm) { gm = gl[i]; g = i; }
            float gs = 0.f;
#pragma unroll
            for (int i = 0; i < 4; ++i) gs += __expf(gl[i] - gm);
            const float pgrp = 1.0f / gs;
            float v0 = -3.0e38f, v1 = -3.0e38f; int i0 = 0, i1 = 0;
#pragma unroll
            for (int i = 0; i < 8; ++i) { const float v = rs * lg[4 + 8 * g + i] + lbias[4 + 8 * g + i];
                if (v > v0) { v1 = v0; i1 = i0; v0 = v; i0 = i; } else if (v > v1) { v1 = v; i1 = i; } }
            const float ex = __expf(v1 - v0); w0 = pgrp / (1.0f + ex); w1 = pgrp * ex / (1.0f + ex);
            e0 = 8 * g + i0; e1 = 8 * g + i1;
            p0 = __hip_atomic_fetch_add(lcnt + e0, 1, __ATOMIC_RELAXED, __HIP_MEMORY_SCOPE_WORKGROUP); p1 = __hip_atomic_fetch_add(lcnt + e1, 1, __ATOMIC_RELAXED, __HIP_MEMORY_SCOPE_WORKGROUP);
        }
        __syncthreads();
        if (tid < 32) { const int n = lcnt[tid]; gbase[tid] = n ? (int)atomicAdd(gcnt + tid, (unsigned)n) : 0; }
        __syncthreads();
        if (lane < 16) {
            const int tok = tokb + lane; p0 += gbase[e0]; p1 += gbase[e1];
            list[(size_t)e0 * LCAP + p0] = tok; list[(size_t)e1 * LCAP + p1] = tok; lrs[(size_t)e0 * LCAP + p0] = rs; lrs[(size_t)e1 * LCAP + p1] = rs;
            *(u32x4*)(tokinfo + (size_t)tok * 8) = (u32x4){(unsigned)e0, (unsigned)p0, __float_as_uint(w0), (unsigned)e1};
            *(u32x4*)(tokinfo + (size_t)tok * 8 + 4) = (u32x4){(unsigned)p1, __float_as_uint(w1), 0u, 0u};
        }
        __syncthreads();
    }
}
__device__ __forceinline__ void moe_tiles(Frame& F) {
    LAS int* tb = (LAS int*)(F.lds + TB_OFF); LAS int* cn = (LAS int*)(F.lds + CNT_OFF);
    __syncthreads();
    if (F.tid < 64) {
        const int e = F.tid & 31;
        const int c = (int)__hip_atomic_load(F.ctl + CW_CNT + e, __ATOMIC_RELAXED, __HIP_MEMORY_SCOPE_AGENT);
        const int t = (c + 255) >> 8; int inc = t;
#pragma unroll
        for (int o = 1; o < 32; o <<= 1) { const int v = __shfl_up(inc, o); if ((F.tid & 63) >= o) inc += v; }
        if (F.tid < 32) { cn[e] = c; tb[e] = inc - t; if (e == 31) tb[NE] = inc; }
    }
    __syncthreads();
}
__device__ __forceinline__ void p7_final(Frame& F, float* out, const float* gfin) {
    const unsigned char* y2 = (const unsigned char*)(F.ws + WS_Y2); const bf16_t* x1b = (const bf16_t*)(F.ws + WS_X1B); const unsigned* tokinfo = (const unsigned*)(F.ws + WS_TOKINFO);
    const LAS int* tb = (const LAS int*)(F.lds + TB_OFF);
    const int gw = F.vcu * 8 + F.wave, NGW = F.G * 8;
    f32x4 gf[4];
#pragma unroll
    for (int j = 0; j < 4; ++j) gf[j] = ((const f32x4*)gfin)[64 * j + F.lane];
    const float ys = 1.0f / (float)(1 << FP8_Y_SHIFT);
    for (int m0 = gw * 2; m0 < NTOK; m0 += NGW * 2) {
        u32x2 xv[2][4]; unsigned ya[2][4], yb[2][4]; float w0s[2], w1s[2];
#pragma unroll
        for (int rr = 0; rr < 2; ++rr) { const int m = m0 + rr;
            const u32x4 i0 = *(const u32x4*)(tokinfo + (size_t)m * 8), i1 = *(const u32x4*)(tokinfo + (size_t)m * 8 + 4);
            const int e0 = (int)i0.x, p0 = (int)i0.y, e1 = (int)i0.w, p1 = (int)i1.x; w0s[rr] = __uint_as_float(i0.z) * ys; w1s[rr] = __uint_as_float(i1.y) * ys;
            const size_t r0 = (size_t)tb[e0] * 256 + p0, r1 = (size_t)tb[e1] * 256 + p1;
            const u32x2* xr = (const u32x2*)(x1b + (size_t)m * D) + F.lane; const unsigned* pa = (const unsigned*)(y2 + r0 * D) + F.lane; const unsigned* pb = (const unsigned*)(y2 + r1 * D) + F.lane;
#pragma unroll
            for (int j = 0; j < 4; ++j) { xv[rr][j] = xr[64 * j]; ya[rr][j] = pa[64 * j]; yb[rr][j] = pb[64 * j]; } }
#pragma unroll
        for (int rr = 0; rr < 2; ++rr) {
            f32x4 v[4]; float ss = 0.f;
#pragma unroll
            for (int j = 0; j < 4; ++j) { const unsigned a = ya[rr][j], bq = yb[rr][j];
                const f32x2 a01 = __builtin_amdgcn_cvt_pk_f32_fp8((int)a, false), a23 = __builtin_amdgcn_cvt_pk_f32_fp8((int)a, true);
                const f32x2 b01 = __builtin_amdgcn_cvt_pk_f32_fp8((int)bq, false), b23 = __builtin_amdgcn_cvt_pk_f32_fp8((int)bq, true);
                v[j].x = bflo(xv[rr][j].x) + w0s[rr] * a01.x + w1s[rr] * b01.x; v[j].y = bfhi(xv[rr][j].x) + w0s[rr] * a01.y + w1s[rr] * b01.y;
                v[j].z = bflo(xv[rr][j].y) + w0s[rr] * a23.x + w1s[rr] * b23.x; v[j].w = bfhi(xv[rr][j].y) + w0s[rr] * a23.y + w1s[rr] * b23.y;
                ss += (v[j].x * v[j].x + v[j].y * v[j].y) + (v[j].z * v[j].z + v[j].w * v[j].w); }
            ss = wave_sum(ss);
            const float rs = 1.0f / sqrtf(ss * (1.0f / D) + RMS_EPS);
            f32x4* orow = (f32x4*)(out + (size_t)(m0 + rr) * D) + F.lane;
#pragma unroll
            for (int j = 0; j < 4; ++j) { const f32x4 ov = v[j] * rs * gf[j]; asm volatile("global_store_dwordx4 %0, %1, off sc1\n\ts_nop 1" :: "v"(orow + 64 * j), "v"(ov) : "memory"); }
        }
    }
}

constexpr int NPHASE = 8;
__global__ void __launch_bounds__(512, 2) hymba_fwd(Args args) {
    extern __shared__ __attribute__((aligned(16))) unsigned char lds_raw[];
    Frame F;
    F.lds = (LAS unsigned char*)lds_raw; F.ws = args.ws; F.ctl = (unsigned*)(args.ws + WS_CTL);
    F.tid = threadIdx.x; F.lane = F.tid & 63; F.wave = __builtin_amdgcn_readfirstlane(F.tid >> 6);
    F.G = gridDim.x; { const int bx = blockIdx.x; F.vcu = (F.G % 8 == 0) ? (bx % 8) * (F.G / 8) + bx / 8 : bx; }
    for (int u = F.tid; u < (LDS_BYTES - LDSCTL_OFF) / 4; u += 512) ((LAS unsigned*)(F.lds + LDSCTL_OFF))[u] = 0u;
    __syncthreads();
    const int lo = args.ph_lo, hi = args.ph_hi;
    XcdBarrier bar; bar.bar = F.ctl + CW_BAR; bar.x = 0; bar.st = nullptr;
    if (hi - lo > 1) bar = xcd_barrier_post(F.ctl + CW_BAR, (volatile LAS unsigned*)(F.lds + MISC_OFF + 32));
#define REFRESH() do { int t_ = threadIdx.x; asm volatile("" : "+v"(t_)); F.tid = t_; F.lane = t_ & 63; } while (0)
#define IN(k) (lo <= (k) && (k) < hi)
#define SEAM(k) do { if (IN(k) && IN((k) + 1)) xcd_barrier(bar); } while (0)
    unsigned long long pr_t0 = 0, pr_d = 0;
#define PRB0(k) do { if (PROBE_PH == (k) && blockIdx.x == 0) pr_t0 = __builtin_amdgcn_s_memrealtime(); } while (0)
#define PRB1(k) do { if (PROBE_PH == (k) && blockIdx.x == 0) pr_d = __builtin_amdgcn_s_memrealtime() - pr_t0; } while (0)

    PRB0(0);
    if (IN(0)) { REFRESH(); p0_prep(F, args); __syncthreads(); }
    SEAM(0);
    PRB1(0);
    PRB0(1);
    if (IN(1)) { REFRESH();
        pg8::EpiProj E{(bf16_t*)(F.ws + WS_R1), NPROJ, (const float*)(F.ws + WS_WR + 128 * 1024), (const float*)(F.ws + WS_RS1)};
        const int bxr = (int)blockIdx.x, locr = bxr >> 3; const bool convwg = (locr & 1) != 0, lateg = ((locr >> 1) & 1) != 0;
        const int ridx = (bxr & 7) * 16 + (locr >> 1);
        if (convwg) { ml_gates(F, ridx, true); if (lateg) expert_queue(F, args, false, 1); }
        { pg8::ProjOrder S{(int)blockIdx.x, 0, convwg ? 4 : 6, (const char*)(F.ws + WS_R2), (const char*)(F.ws + WS_WIN), D, D, F.ctl + CW_DEP_QK, bar.x, bar.st};
          pg8::gemm_phase<pg8::EpiProj, pg8::ProjOrder>(F.lds, D, S, E); }
        if (convwg) {
            dep_post(bar, F.ctl + CW_DEP_QK);
            p1_wout(F, args, ridx);
            expert_queue(F, args, false, 1 << 30, lateg ? 2048 : 0);
            pg8::ProjOrder S{(int)blockIdx.x, 4, 4, (const char*)(F.ws + WS_R2), (const char*)(F.ws + WS_WIN), D, D, F.ctl + CW_DEP_QK, bar.x, bar.st};
            pg8::gemm_phase<pg8::EpiProj, pg8::ProjOrder>(F.lds, D, S, E);
        }
        dep_post(bar, F.ctl + CW_DEP_CV);
    }
    PRB1(1);
    PRB0(2);
    if (IN(2)) { REFRESH();
        const int bxr = (int)blockIdx.x, locr = bxr >> 3, ridx = (bxr & 7) * 16 + (locr >> 1);
        if ((locr & 1) == 0) { dep_wait(bar, F.ctl + CW_DEP_QK); mlstm_unit(F, ridx, 2); }
        else {
            dep_wait(bar, F.ctl + CW_DEP_CV);
            conv_part(F, args.in[4], ridx);
        }
        expert_queue(F, args, false);
    }
    SEAM(2);
    PRB1(2);
    PRB0(3);
    if (IN(3)) { REFRESH();
        constexpr int sy = 0x01010101 * (127 - FP8_YM_SHIFT), sw = 0x01010101 * (127 - FP8_W_SHIFT);
        pg8::DenseOrder8 S{NTOK / 256, D / 256, F.G, (int)blockIdx.x, D / 2, (const char*)(F.ws + WS_YMC), (const char*)(F.ws + WS_WOUT), D / 2, D / 2, sy, sw};
        pg8::EpiAddBf16 E{(const bf16_t*)(F.ws + WS_R2), (bf16_t*)(F.ws + WS_X1B), D};
        pg8::gemm_phase<pg8::EpiAddBf16, pg8::DenseOrder8>(F.lds, D / 2, S, E);
    }
    SEAM(3);
    PRB1(3);
    PRB0(4);
    if (IN(4)) { REFRESH(); p4_router(F); }
    SEAM(4);
    PRB1(4);
    PRB0(5);
    if (IN(5)) { REFRESH();
        moe_tiles(F);
        const LAS int* tb = (const LAS int*)(F.lds + TB_OFF); const LAS int* cn = (const LAS int*)(F.lds + CNT_OFF);
        constexpr int s1 = 0x01010101 * 127, sw = 0x01010101 * (127 - FP8_W_SHIFT);
        pg8::MoeOrder<true> S{tb[NE], 4, F.G, (int)blockIdx.x, D / 2, (const char*)(F.ws + WS_X1Q), (const char*)(F.ws + WS_W1), (size_t)1024 * 1024, (const int*)(F.ws + WS_LIST), tb, cn, D / 2, D / 2, s1, sw};
        pg8::EpiSwiglu E{(unsigned char*)(F.ws + WS_HBUF), (const float*)(F.ws + WS_LRS)};
        pg8::gemm_phase<pg8::EpiSwiglu, pg8::MoeOrder<true>>(F.lds, D / 2, S, E);
        expert_queue(F, args, true);
    }
    SEAM(5);
    PRB1(5);
    PRB0(6);
    if (IN(6)) { REFRESH();
        if (!IN(5)) moe_tiles(F);
        const LAS int* tb = (const LAS int*)(F.lds + TB_OFF); const LAS int* cn = (const LAS int*)(F.lds + CNT_OFF);
        constexpr int sh = 0x01010101 * (127 - FP8_H_SHIFT), sw = 0x01010101 * (127 - FP8_W_SHIFT);
        pg8::MoeOrder<false> S{tb[NE], 4, F.G, (int)blockIdx.x, DFF / 2, (const char*)(F.ws + WS_HBUF), (const char*)(F.ws + WS_W2), (size_t)1024 * 512, nullptr, tb, cn, DFF / 2, DFF / 2, sh, sw};
        pg8::EpiFp8 E{(unsigned char*)(F.ws + WS_Y2), D};
        pg8::gemm_phase<pg8::EpiFp8, pg8::MoeOrder<false>>(F.lds, DFF / 2, S, E);
    }
    SEAM(6);
    PRB1(6);
    PRB0(7);
    if (IN(7)) { REFRESH(); if (!IN(5)) moe_tiles(F); p7_final(F, args.out, args.in[14]); }
    PRB1(7);
    if (PROBE_PH >= 0 && blockIdx.x == 0) { const unsigned long long t0 = __builtin_amdgcn_s_memrealtime(); while (__builtin_amdgcn_s_memrealtime() - t0 < pr_d) __builtin_amdgcn_s_sleep(8); }
#undef IN
#undef SEAM
}

extern "C" void kernel_launch(void* const* d_in, const int* in_sizes, int n_in, void* d_out, int out_size, void* d_ws, size_t ws_size, hipStream_t stream) {
    static int grid = 0;
    if (grid == 0) {
        if (n_in != 15 || in_sizes[0] != NTOK * D || out_size != NTOK * D || ws_size < WS_END) { fprintf(stderr, "kernel_launch: unexpected shapes / workspace (n_in %d, ws %zu)\n", n_in, ws_size); grid = -1; return; }
        int dev = 0, cus = 0;
        if (hipGetDevice(&dev) != hipSuccess || hipDeviceGetAttribute(&cus, hipDeviceAttributeMultiprocessorCount, dev) != hipSuccess) { grid = -1; return; }
        if (hipFuncSetAttribute((const void*)hymba_fwd, hipFuncAttributeMaxDynamicSharedMemorySize, LDS_BYTES) != hipSuccess) { fprintf(stderr, "kernel_launch: hipFuncSetAttribute failed\n"); grid = -1; return; }
        int per_cu = 0;
        (void)hipOccupancyMaxActiveBlocksPerMultiprocessor(&per_cu, (const void*)hymba_fwd, 512, LDS_BYTES);
        (void)hipGetLastError();
        grid = cus;
    }
    if (grid < 0) return;
    (void)hipMemsetAsync((char*)d_ws + WS_CTL, 0, CTL_ZERO_BYTES, stream);
    Args a{};
    for (int i = 0; i < 15; ++i) a.in[i] = (const float*)d_in[i];
    a.out = (float*)d_out; a.ws = (unsigned char*)d_ws;
    if (MK_N_LAUNCHES == 1) { a.ph_lo = 0; a.ph_hi = NPHASE; hipLaunchKernelGGL(hymba_fwd, dim3(grid), dim3(512), LDS_BYTES, stream, a); }
    else for (int p = 0; p < NPHASE; ++p) { a.ph_lo = p; a.ph_hi = p + 1; hipLaunchKernelGGL(hymba_fwd, dim3(grid), dim3(512), LDS_BYTES, stream, a); }
}
```
